# Optimizing an MI355X kernel written in HIP

```python
import math
import jax
import jax.numpy as jnp
from jax import lax
import numpy as np


D_MODEL = 1024
BATCH = 8
SEQ = 4096
DEPTH = 1

D_MIX = D_MODEL
D_LRU = D_MIX // 2
LRU_BLOCKS = 8
LRU_BLOCK = D_LRU // LRU_BLOCKS
LRU_C = 8.0
CONV_W = 4
CONV_LEFT = 2
N_ATT_HEADS = 4
D_ATT = D_MIX - D_LRU
HEAD_DV = D_ATT // N_ATT_HEADS
HEAD_DK = HEAD_DV // 2
QK_W = N_ATT_HEADS * 2 * HEAD_DK
D_IN_PROJ = 2 * D_LRU + 2 * QK_W + D_ATT
SPLITS = [D_LRU, 2 * D_LRU, 2 * D_LRU + QK_W, 2 * D_LRU + 2 * QK_W]
N_BUCKETS = 32
MAX_DISTANCE = 128
Q_BLOCK = 128
N_EXPERTS = 16
EC_FACTOR = 2
D_FF_EXPERT = D_MODEL
EPS = 1e-6

kernel_name = 'hybrid_rglru_diffattn_ecmoe_block'


def rms_norm(x, g):
    xf = x.astype(jnp.float32)
    y = xf * lax.rsqrt(jnp.mean(xf * xf, axis=-1, keepdims=True) + EPS)
    return (y * g.astype(jnp.float32)).astype(x.dtype)


def t5_buckets(rel):
    half = N_BUCKETS // 2
    max_exact = half // 2
    ret = jnp.where(rel > 0, half, 0)
    n = jnp.abs(rel)
    nf = jnp.maximum(n, 1).astype(jnp.float32)
    large = max_exact + (jnp.log(nf / max_exact) / math.log(MAX_DISTANCE / max_exact)
                         * (half - max_exact)).astype(jnp.int32)
    large = jnp.minimum(large, half - 1)
    return ret + jnp.where(n < max_exact, n, large)


def rg_lru(xc, w_a, b_a, w_x, b_x, lam, reverse):
    B, S, _ = xc.shape
    xb = xc.reshape(B, S, LRU_BLOCKS, LRU_BLOCK)
    r = jax.nn.sigmoid((jnp.einsum('bsnc,ncd->bsnd', xb, w_a).reshape(B, S, D_LRU) + b_a).astype(jnp.float32))
    i = jax.nn.sigmoid((jnp.einsum('bsnc,ncd->bsnd', xb, w_x).reshape(B, S, D_LRU) + b_x).astype(jnp.float32))
    log_a = LRU_C * r * jax.nn.log_sigmoid(lam.astype(jnp.float32))
    a = jnp.exp(log_a)
    u = jnp.sqrt(-jnp.expm1(2.0 * log_a)) * (i * xc.astype(jnp.float32))

    def combine(left, right):
        a1, b1 = left
        a2, b2 = right
        return a1 * a2, a2 * b1 + b2

    _, h = lax.associative_scan(combine, (a, u), axis=1, reverse=reverse)
    return h.astype(xc.dtype)


def diff_attention(q, k, v, g_q, g_k, lam, g_o, bias_table, lam_init):
    B, S = q.shape[0], q.shape[1]
    q = rms_norm(q, g_q) * (HEAD_DK ** -0.5)
    k = rms_norm(k, g_k)
    nb = S // Q_BLOCK
    qb = q.reshape(B, nb, Q_BLOCK, N_ATT_HEADS, 2, HEAD_DK).transpose(1, 0, 2, 3, 4, 5)
    kpos = jnp.arange(S, dtype=jnp.int32)

    def block(args):
        qi, start = args
        qpos = start + jnp.arange(Q_BLOCK, dtype=jnp.int32)
        bias = bias_table[t5_buckets(kpos[None, :] - qpos[:, None])].astype(jnp.float32)
        bias = bias.transpose(2, 0, 1)
        s = jnp.einsum('bqhjd,bkhjd->bhjqk', qi, k).astype(jnp.float32) + bias[None, :, None]
        p = jax.nn.softmax(s, axis=-1)
        w = (p[:, :, 0] - lam * p[:, :, 1]).astype(v.dtype)
        return jnp.einsum('bhqk,bkhd->bqhd', w, v)

    o = lax.map(block, (qb, jnp.arange(nb, dtype=jnp.int32) * Q_BLOCK))
    o = o.transpose(1, 0, 2, 3, 4).reshape(B, S, N_ATT_HEADS, HEAD_DV)
    o = rms_norm(o, g_o) * (1.0 - lam_init)
    return o.reshape(B, S, D_ATT)


def expert_choice_ffn(h, w_router, w1, w3, w2):
    B, S, D = h.shape
    cap = max(1, EC_FACTOR * S // N_EXPERTS)
    aff = jax.nn.softmax(jnp.dot(h, w_router).astype(jnp.float32), axis=-1)
    g, idx = lax.top_k(aff.transpose(0, 2, 1), cap)
    xe = jax.vmap(lambda hb, ib: hb[ib])(h, idx)
    a = jnp.einsum('becd,edf->becf', xe, w1)
    b = jnp.einsum('becd,edf->becf', xe, w3)
    y = jnp.einsum('becf,efd->becd', jax.nn.silu(a) * b, w2)
    y = y * g[..., None].astype(y.dtype)
    return jax.vmap(lambda ib, yb: jnp.zeros((S, D), yb.dtype).at[ib.reshape(-1)].add(yb.reshape(-1, D)))(idx, y)


def setup_inputs(seed: int = 0) -> dict:
    key = jax.random.key(seed)
    ks = jax.random.split(key, 26)
    f32 = jnp.float32

    def nrm(k, shape, fan_in):
        return jax.random.normal(k, shape, f32) * (fan_in ** -0.5)

    def gain(k, shape):
        return 1.0 + 0.02 * jax.random.normal(k, shape, f32)

    a0 = jax.random.uniform(ks[12], (DEPTH, 2, D_LRU), f32, minval=0.9, maxval=0.999)
    return {
        'x': jax.random.normal(ks[0], (BATCH, SEQ, D_MODEL), f32),
        'c': jax.random.normal(ks[1], (BATCH, D_MODEL), f32),
        'w_mod': nrm(ks[2], (DEPTH, D_MODEL, 6 * D_MODEL), D_MODEL),
        'b_mod': 0.02 * jax.random.normal(ks[3], (DEPTH, 6 * D_MODEL), f32),
        'g_norm1': gain(ks[4], (DEPTH, D_MODEL)),
        'w_in': nrm(ks[5], (DEPTH, D_MODEL, D_IN_PROJ), D_MODEL),
        'conv_w': nrm(ks[6], (DEPTH, CONV_W, 1, D_LRU), CONV_W),
        'conv_b': 0.02 * jax.random.normal(ks[7], (DEPTH, D_LRU), f32),
        'lru_w_a': nrm(ks[8], (DEPTH, 2, LRU_BLOCKS, LRU_BLOCK, LRU_BLOCK), LRU_BLOCK),
        'lru_b_a': 0.1 * jax.random.normal(ks[9], (DEPTH, 2, D_LRU), f32),
        'lru_w_x': nrm(ks[10], (DEPTH, 2, LRU_BLOCKS, LRU_BLOCK, LRU_BLOCK), LRU_BLOCK),
        'lru_b_x': 0.1 * jax.random.normal(ks[11], (DEPTH, 2, D_LRU), f32),
        'lru_lambda': jnp.log(a0) - jnp.log1p(-a0),
        'g_q': gain(ks[13], (DEPTH, HEAD_DK)),
        'g_k': gain(ks[14], (DEPTH, HEAD_DK)),
        'lambda_qk': 0.1 * jax.random.normal(ks[15], (DEPTH, 4, HEAD_DK), f32),
        'g_attn_out': gain(ks[16], (DEPTH, HEAD_DV)),
        'rel_bias': 0.5 * jax.random.normal(ks[17], (N_BUCKETS, N_ATT_HEADS), f32),
        'w_out': nrm(ks[18], (DEPTH, D_MIX, D_MODEL), D_MIX),
        'g_norm2': gain(ks[19], (DEPTH, D_MODEL)),
        'w_router': nrm(ks[20], (DEPTH, D_MODEL, N_EXPERTS), D_MODEL),
        'w1': nrm(ks[21], (DEPTH, N_EXPERTS, D_MODEL, D_FF_EXPERT), D_MODEL),
        'w3': nrm(ks[22], (DEPTH, N_EXPERTS, D_MODEL, D_FF_EXPERT), D_MODEL),
        'w2': nrm(ks[23], (DEPTH, N_EXPERTS, D_FF_EXPERT, D_MODEL), D_FF_EXPERT),
    }


def reference(x, c, w_mod, b_mod, g_norm1, w_in, conv_w, conv_b, lru_w_a, lru_b_a, lru_w_x, lru_b_x,
              lru_lambda, g_q, g_k, lambda_qk, g_attn_out, rel_bias, w_out, g_norm2, w_router, w1, w3, w2):
    B, S, _ = x.shape
    for l in range(DEPTH):
        mod = jnp.dot(jax.nn.silu(c), w_mod[l]) + b_mod[l]
        shift1, scale1, gate1, shift2, scale2, gate2 = jnp.split(mod[:, None, :], 6, axis=-1)

        h = rms_norm(x, g_norm1[l]) * (1.0 + scale1) + shift1
        proj = jnp.dot(h, w_in[l])
        x_lru, z_lru, q, k, v = jnp.split(proj, SPLITS, axis=-1)

        xc = lax.conv_general_dilated(x_lru, conv_w[l], (1,), [(CONV_LEFT, CONV_W - 1 - CONV_LEFT)],
                                      dimension_numbers=('NWC', 'WIO', 'NWC'),
                                      feature_group_count=D_LRU) + conv_b[l]
        h_fwd = rg_lru(xc, lru_w_a[l, 0], lru_b_a[l, 0], lru_w_x[l, 0], lru_b_x[l, 0], lru_lambda[l, 0], False)
        h_bwd = rg_lru(xc, lru_w_a[l, 1], lru_b_a[l, 1], lru_w_x[l, 1], lru_b_x[l, 1], lru_lambda[l, 1], True)
        y_lru = (h_fwd + h_bwd) * jax.nn.gelu(z_lru)

        lam_init = 0.8 - 0.6 * math.exp(-0.3 * l)
        lq = lambda_qk[l].astype(jnp.float32)
        lam = jnp.exp(jnp.sum(lq[0] * lq[1])) - jnp.exp(jnp.sum(lq[2] * lq[3])) + lam_init
        y_att = diff_attention(q.reshape(B, S, N_ATT_HEADS, 2, HEAD_DK),
                               k.reshape(B, S, N_ATT_HEADS, 2, HEAD_DK),
                               v.reshape(B, S, N_ATT_HEADS, HEAD_DV),
                               g_q[l], g_k[l], lam, g_attn_out[l], rel_bias, lam_init)

        mix = jnp.dot(jnp.concatenate([y_lru, y_att], axis=-1), w_out[l])
        x = x + gate1 * mix

        h2 = rms_norm(x, g_norm2[l]) * (1.0 + scale2) + shift2
        x = x + gate2 * expert_choice_ffn(h2, w_router[l], w1[l], w3[l], w2[l])
    return x
```

```cpp
#include <hip/hip_runtime.h>
#include <cstdint>
#include <cstdio>

#ifndef MK_SINGLE
#define MK_SINGLE 1
#endif

#define DEV __device__ __forceinline__
#define GAS __attribute__((address_space(1)))
#define LAS __attribute__((address_space(3)))
typedef unsigned short bf16;
typedef short bf16x8 __attribute__((ext_vector_type(8)));
typedef float f32x16 __attribute__((ext_vector_type(16)));
typedef float f32x4 __attribute__((ext_vector_type(4)));
typedef unsigned u32x4 __attribute__((ext_vector_type(4)));
typedef int i32x4 __attribute__((ext_vector_type(4)));
typedef float f32x2 __attribute__((ext_vector_type(2)));
typedef unsigned u32x2 __attribute__((ext_vector_type(2)));

constexpr int NB = 8, S = 4096, D = 1024, T = NB * S;
constexpr int DL = 512, NPROJ = 2560, NE = 16, CAP = 512, NH = 4;
constexpr float EPS = 1e-6f;
constexpr float LAM_INIT = 0.2f;
constexpr int NTHR = 512, NWAVE = 8;

constexpr size_t MiB = 1u << 20;
constexpr size_t WS_PROJ = 0;
constexpr size_t WS_HB = 0;
constexpr size_t WS_H = 160 * MiB;
constexpr size_t WS_XCG = 160 * MiB;
constexpr size_t WS_AF = 160 * MiB;
constexpr size_t WS_YB = 160 * MiB;
constexpr size_t WS_YCAT = 224 * MiB;
constexpr size_t WS_XC = 224 * MiB;
constexpr size_t WS_H2 = 288 * MiB;
constexpr size_t WS_UF = 288 * MiB;
constexpr size_t WS_QK8 = 288 * MiB;
constexpr size_t WS_WIN = 352 * MiB;
constexpr size_t WS_WOUT = 357 * MiB;
constexpr size_t WS_W1 = 360 * MiB;
constexpr size_t WS_W3 = 392 * MiB;
constexpr size_t WS_W2 = 424 * MiB;
constexpr size_t WS_CTL = 456 * MiB;
constexpr size_t WS_MOD = 457 * MiB;
constexpr size_t WS_AFF = 458 * MiB;
constexpr size_t WS_IDX = 460 * MiB;
constexpr size_t WS_GVAL = 460 * MiB + 512 * 1024;
constexpr size_t WS_SEL = 461 * MiB;
constexpr size_t WS_BIAS = 463 * MiB;
constexpr size_t WS_LSUM = 463 * MiB + 512 * 1024;
constexpr size_t WS_END = 464 * MiB;

constexpr int X1_LD = 2048, X1_OFF = 1024;
struct Params { const float* in[24]; float* out; unsigned char* ws; };

DEV float bf2f(bf16 v) { return __uint_as_float((unsigned)v << 16); }
DEV unsigned f2bf(float f) { unsigned u = __float_as_uint(f); return (u + 0x7fffu + ((u >> 16) & 1u)) >> 16; }
DEV unsigned pk2(float lo, float hi) { return f2bf(lo) | (f2bf(hi) << 16); }
DEV float wave_sum(float v) {
#pragma unroll
    for (int o = 1; o < 64; o <<= 1) v += __shfl_xor(v, o);
    return v;
}
DEV float sigmoidf_(float x) { return 1.f / (1.f + __expf(-x)); }
DEV float siluf_(float x) { return x / (1.f + __expf(-x)); }
DEV float gelu_tanh(float x) { const float u = 0.7978845608028654f * (x + 0.044715f * x * x * x); return 0.5f * x * (1.f + tanhf(u)); }
DEV float clamp_f8(float v) { return __builtin_amdgcn_fmed3f(v, -448.f, 448.f); }
DEV unsigned pk4_fp8(float a, float b, float c, float d) { int p = 0; p = __builtin_amdgcn_cvt_pk_fp8_f32(clamp_f8(a), clamp_f8(b), p, false); p = __builtin_amdgcn_cvt_pk_fp8_f32(clamp_f8(c), clamp_f8(d), p, true); return (unsigned)p; }
#define LDS_WAIT() asm volatile("s_waitcnt lgkmcnt(0)" ::: "memory")
constexpr int LDS_TIDTAB = 131072 + 12288;
DEV unsigned hw_wave_key() { return (unsigned)__builtin_amdgcn_s_getreg((5 << 11) | 4) & 63u; }
DEV int lane_id() { return (int)__builtin_amdgcn_mbcnt_hi(~0u, __builtin_amdgcn_mbcnt_lo(~0u, 0u)); }
DEV void tid_table_init() { if (lane_id() == 0) ((volatile LAS unsigned*)LDS_TIDTAB)[hw_wave_key()] = threadIdx.x; }
DEV int phase_tid() { int t = (int)((volatile LAS unsigned*)LDS_TIDTAB)[hw_wave_key()] + lane_id(); asm volatile("" : "+v"(t)); return t; }

#define XB_TMO      128
#define XB_XCNT(j)  (256  + 64 * (j))
#define XB_XSUB(j)  (1280 + 64 * (j))
#define XB_XGEN(j)  (2304 + 64 * (j))
#define XB_TOP      3328
#define XB_TOPGEN   3392
#define XCD_BAR_WORDS 3456
#define XB_SPIN_CAP (1u << 22)
DEV unsigned xb_ld(unsigned* p)              { return __hip_atomic_load(p, __ATOMIC_RELAXED, __HIP_MEMORY_SCOPE_AGENT); }
DEV unsigned xb_add(unsigned* p, unsigned v) { return __hip_atomic_fetch_add(p, v, __ATOMIC_RELAXED, __HIP_MEMORY_SCOPE_AGENT); }
DEV unsigned xb_xcc_id() { return (unsigned)__builtin_amdgcn_s_getreg((3 << 11) | 20) & 0xFu; }
#define XB_SPIN(cond, bar) do { unsigned _sp = 0; while (cond) { __builtin_amdgcn_s_sleep(1); \
    if ((++_sp & 255u) == 0u) { if (xb_ld(&(bar)[XB_TMO])) break; if (_sp > XB_SPIN_CAP) { atomicAdd(&(bar)[XB_TMO], 1u); break; } } } } while (0)
struct XcdBarrier { unsigned* bar; unsigned x; volatile LAS unsigned* st; };
DEV XcdBarrier xcd_barrier_post(unsigned* bar, volatile LAS unsigned* st) {
    XcdBarrier b; b.bar = bar; b.x = xb_xcc_id(); b.st = st;
    if (threadIdx.x == 0) (void)xb_add(&bar[XB_XCNT(b.x)], 1u);
    return b;
}
DEV void xcd_barrier_complete(unsigned* bar, unsigned x, unsigned& nloc, unsigned& nx) {
    const unsigned G = gridDim.x * gridDim.y * gridDim.z;
    unsigned sum, cnt, mine, sp = 0u;
    for (;;) {
        sum = 0u; cnt = 0u; mine = 0u;
#pragma unroll
        for (unsigned j = 0; j < 16; ++j) { const unsigned c = xb_ld(&bar[XB_XCNT(j)]); sum += c; cnt += (c > 0u) ? 1u : 0u; mine = (j == x) ? c : mine; }
        if (sum == G) break;
        __builtin_amdgcn_s_sleep(1);
        if ((++sp & 255u) == 0u) { if (xb_ld(&bar[XB_TMO])) break; if (sp > XB_SPIN_CAP) { atomicAdd(&bar[XB_TMO], 1u); break; } }
    }
    nloc = mine > 0u ? mine : 1u; nx = cnt > 0u ? cnt : 1u;
}
DEV void xcd_barrier(const XcdBarrier& b) {
    asm volatile("s_waitcnt vmcnt(0)" ::: "memory");
    __syncthreads();
    if (phase_tid() == 0) {
        unsigned* bar = b.bar;
        __builtin_amdgcn_s_waitcnt(0);
        unsigned nloc = b.st[0], nx = b.st[1];
        if (nloc == 0u) { xcd_barrier_complete(bar, b.x, nloc, nx); b.st[0] = nloc; b.st[1] = nx; }
        const unsigned old = xb_add(&bar[XB_XSUB(b.x)], 1u);
        const unsigned gen = old / nloc;
        if (old + 1u == (gen + 1u) * nloc) {
            __builtin_amdgcn_fence(__ATOMIC_RELEASE, "agent");
            asm volatile("s_waitcnt vmcnt(0)" ::: "memory");
            const unsigned og = xb_add(&bar[XB_TOP], 1u);
            const unsigned tg = og / nx;
            if (og + 1u == (tg + 1u) * nx) xb_add(&bar[XB_TOPGEN], 1u);
            else XB_SPIN(xb_ld(&bar[XB_TOPGEN]) == tg, bar);
            __builtin_amdgcn_fence(__ATOMIC_ACQUIRE, "agent");
            xb_add(&bar[XB_XGEN(b.x)], 1u);
            asm volatile("s_waitcnt vmcnt(0)" ::: "memory");
        } else {
            XB_SPIN(xb_ld(&bar[XB_XGEN(b.x)]) == gen, bar);
            __builtin_amdgcn_fence(__ATOMIC_ACQUIRE, "agent");
            asm volatile("s_waitcnt vmcnt(0)" ::: "memory");
        }
    }
    __syncthreads();
}

constexpr int LDS_SCRATCH = 0;
constexpr int LDS_MISC = 131072;
constexpr int LDS_BYTES = 147456;

DEV void transpose_item(const float* W, int K, int N, bf16* WT, float* scr, int item, int lane) {
    const int nblk = N / 32, kb = item / nblk, nbk = item % nblk, k0 = 64 * kb, n0 = 32 * nbk;
#pragma unroll 8
    for (int i = 0; i < 32; ++i) { const int kk = 2 * i + (lane >> 5); scr[kk * 33 + (lane & 31)] = W[(size_t)(k0 + kk) * N + n0 + (lane & 31)]; }
    LDS_WAIT();
    const int c = lane & 7;
#pragma unroll
    for (int j = 0; j < 4; ++j) { const int n = (lane >> 3) + 8 * j; const float* s = scr + (8 * c) * 33 + n;
        u32x4 o; o.x = pk2(s[0 * 33], s[1 * 33]); o.y = pk2(s[2 * 33], s[3 * 33]); o.z = pk2(s[4 * 33], s[5 * 33]); o.w = pk2(s[6 * 33], s[7 * 33]);
        *(u32x4*)(WT + (size_t)(n0 + n) * K + k0 + 8 * c) = o; }
    LDS_WAIT();
}
DEV void transpose_item_f8(const float* W, int K, int N, unsigned char* WT, float* scr, int item, int lane) {
    const int nblk = N / 32, kb = item / nblk, nbk = item % nblk, k0 = 64 * kb, n0 = 32 * nbk;
#pragma unroll 8
    for (int i = 0; i < 32; ++i) { const int kk = 2 * i + (lane >> 5); scr[kk * 33 + (lane & 31)] = W[(size_t)(k0 + kk) * N + n0 + (lane & 31)]; }
    LDS_WAIT();
    const int c = lane & 7;
#pragma unroll
    for (int j = 0; j < 4; ++j) { const int n = (lane >> 3) + 8 * j; const float* s = scr + (8 * c) * 33 + n;
        int p0 = 0, p1 = 0;
        p0 = __builtin_amdgcn_cvt_pk_fp8_f32(s[0 * 33], s[1 * 33], p0, false); p0 = __builtin_amdgcn_cvt_pk_fp8_f32(s[2 * 33], s[3 * 33], p0, true);
        p1 = __builtin_amdgcn_cvt_pk_fp8_f32(s[4 * 33], s[5 * 33], p1, false); p1 = __builtin_amdgcn_cvt_pk_fp8_f32(s[6 * 33], s[7 * 33], p1, true);
        *(u32x2*)(WT + (size_t)(n0 + n) * K + k0 + 8 * c) = (u32x2){(unsigned)p0, (unsigned)p1}; }
    LDS_WAIT();
}
DEV int t5_bucket(int rel) {
    const int ret = rel > 0 ? 16 : 0; const int n = rel < 0 ? -rel : rel;
    if (n < 8) return ret + n;
    const int l2 = 31 - __clz(n * n);
    int large = 8 + l2 - 6; if (large > 15) large = 15;
    return ret + large;
}
DEV void ph_mod(const Params& P, int bid, int nb, unsigned char* lds) {
    const int tid = phase_tid(), lane = tid & 63, wave = tid >> 6;
    float* sc = (float*)lds;
    float* red = (float*)lds + 8 * 1024;
    const float* c = P.in[1]; const float* wm = P.in[2]; const float* bm = P.in[3];
    float* mod = (float*)(P.ws + WS_MOD);
    __syncthreads();
    for (int i = tid; i < NB * D; i += NTHR) sc[i] = siluf_(c[i]);
    __syncthreads();
    constexpr int CPB = 24;
    for (int it = bid; it < 6 * D / CPB; it += nb) {
        const int j0 = it * CPB, cg = lane % 6, kr = lane / 6;
        f32x4 acc[8];
#pragma unroll
        for (int b = 0; b < 8; ++b) acc[b] = (f32x4){0.f, 0.f, 0.f, 0.f};
        if (kr < 10) {
            const float* wp = wm + (size_t)(wave * 128 + kr) * (6 * D) + j0 + 4 * cg;
            f32x4 wv[13];
#pragma unroll
            for (int i = 0; i < 13; ++i) wv[i] = (i < 12 || kr < 8) ? *(const f32x4*)(wp + (size_t)(10 * i) * (6 * D)) : (f32x4){0.f, 0.f, 0.f, 0.f};
            const LAS float* scl = (const LAS float*)(LAS unsigned char*)lds + wave * 128 + (kr < 8 ? kr : kr - 10);
            asm volatile("" : "+v"(scl));
#pragma unroll
            for (int i = 0; i < 13; ++i) {
#pragma unroll
                for (int b = 0; b < 8; ++b) { const float sv = scl[b * D + 10 * i + (kr < 8 ? 0 : 10) * (i < 12 ? 1 : 0)]; acc[b] += wv[i] * sv; }
                if ((i & 1) == 1) asm volatile("" ::: "memory"); }
#pragma unroll
            for (int b = 0; b < 8; ++b) *(f32x4*)(red + ((wave * 10 + kr) * 8 + b) * CPB + 4 * cg) = acc[b];
        }
        __syncthreads();
        if (tid < 8 * CPB) { float s_ = 0.f;
#pragma unroll 8
            for (int p_ = 0; p_ < 80; ++p_) s_ += red[p_ * (8 * CPB) + tid];
            const int b = tid / CPB, cc = tid % CPB;
            mod[b * (6 * D) + j0 + cc] = s_ + bm[j0 + cc]; }
        __syncthreads();
    }
}
DEV void ph_prep(const Params& P, int bid, int nb, unsigned char* lds) {
    const int tid = phase_tid(), lane = tid & 63, wave = tid >> 6;
    float* scr = (float*)lds + wave * (64 * 33);
    const int gw = bid * NWAVE + wave, ngw = nb * NWAVE;
    constexpr int I_IN = (D / 64) * (NPROJ / 32);
    for (int it = gw; it < I_IN; it += ngw) transpose_item(P.in[5], D, NPROJ, (bf16*)(P.ws + WS_WIN), scr, it, lane);
}
constexpr int PREP2_IOUT = (D / 64) * (D / 32), PREP2_IE = (D / 64) * (D / 32), PREP2_NIT = PREP2_IOUT + 3 * NE * PREP2_IE;
struct Prep2Item { const float* src; unsigned char* dst; int k0, n0; bool f8; };
DEV bool prep2_decode(const Params& P, int it, Prep2Item& pi) {
    if (it >= PREP2_NIT) return false;
    int r = it;
    if (r < PREP2_IOUT) { pi.src = P.in[18]; pi.dst = P.ws + WS_WOUT; pi.f8 = false; }
    else { r -= PREP2_IOUT; const int which = r / (NE * PREP2_IE); r -= which * (NE * PREP2_IE); const int e = r / PREP2_IE; r -= e * PREP2_IE;
        pi.src = P.in[which == 0 ? 21 : (which == 1 ? 22 : 23)] + (size_t)e * D * D; pi.dst = P.ws + (which == 0 ? WS_W1 : (which == 1 ? WS_W3 : WS_W2)) + (size_t)e * D * D; pi.f8 = true; }
    pi.k0 = 64 * (r / (D / 32)); pi.n0 = 32 * (r % (D / 32)); return true;
}
DEV void prep2_load(const Prep2Item& pi, int lane, float (&tv)[32]) {
    const float* sp = pi.src + (size_t)(pi.k0 + 32 * (lane >> 5)) * D + pi.n0 + (lane & 31);
#pragma unroll
    for (int i = 0; i < 32; ++i) tv[i] = sp[(size_t)i * D];
}
DEV void prep2_finish(const Prep2Item& pi, int lane, const float (&tv)[32]) {
    const size_t o = (size_t)(pi.n0 + (lane & 31)) * D + pi.k0 + 32 * (lane >> 5);
    if (pi.f8) { unsigned w[8];
#pragma unroll
        for (int i = 0; i < 8; ++i) { int p0 = 0; p0 = __builtin_amdgcn_cvt_pk_fp8_f32(tv[4 * i], tv[4 * i + 1], p0, false); p0 = __builtin_amdgcn_cvt_pk_fp8_f32(tv[4 * i + 2], tv[4 * i + 3], p0, true); w[i] = (unsigned)p0; }
        u32x4* d = (u32x4*)(pi.dst + o); d[0] = (u32x4){w[0], w[1], w[2], w[3]}; d[1] = (u32x4){w[4], w[5], w[6], w[7]}; }
    else { u32x4* d = (u32x4*)((bf16*)pi.dst + o);
#pragma unroll
        for (int i = 0; i < 4; ++i) d[i] = (u32x4){pk2(tv[8 * i], tv[8 * i + 1]), pk2(tv[8 * i + 2], tv[8 * i + 3]), pk2(tv[8 * i + 4], tv[8 * i + 5]), pk2(tv[8 * i + 6], tv[8 * i + 7])}; }
}

DEV void ph_h(const Params& P, int bid, int nb) {
    const int tid = phase_tid(), lane = tid & 63, wave = tid >> 6;
    const float* x = P.in[0]; const float* g1 = P.in[4]; const float* mod = (const float*)(P.ws + WS_MOD);
    bf16* h = (bf16*)(P.ws + WS_H);
    const int gw = bid * NWAVE + wave, ngw = nb * NWAVE;
    for (int row0 = gw; row0 < T; row0 += 2 * ngw) {
        f32x4 v[2][4]; int rows[2];
#pragma unroll
        for (int r = 0; r < 2; ++r) { rows[r] = row0 + r * ngw < T ? row0 + r * ngw : row0; const f32x4* xr = (const f32x4*)(x + (size_t)rows[r] * D) + lane;
#pragma unroll
            for (int j = 0; j < 4; ++j) v[r][j] = xr[64 * j]; }
#pragma unroll
        for (int r = 0; r < 2; ++r) {
            if (r > 0 && row0 + r * ngw >= T) break;
            const int row = rows[r], b = row >> 12; float ss = 0.f;
#pragma unroll
            for (int j = 0; j < 4; ++j) ss += (v[r][j].x * v[r][j].x + v[r][j].y * v[r][j].y) + (v[r][j].z * v[r][j].z + v[r][j].w * v[r][j].w);
            const float rstd = rsqrtf(wave_sum(ss) * (1.f / D) + EPS);
            const float* sh = mod + b * 6 * D; const float* scl = sh + D;
#pragma unroll
            for (int j = 0; j < 4; ++j) {
                const int k = 4 * lane + 256 * j;
                const f32x4 g = *(const f32x4*)(g1 + k), s1 = *(const f32x4*)(scl + k), s0 = *(const f32x4*)(sh + k);
                const float o0 = v[r][j].x * rstd * g.x * (1.f + s1.x) + s0.x, o1 = v[r][j].y * rstd * g.y * (1.f + s1.y) + s0.y;
                const float o2 = v[r][j].z * rstd * g.z * (1.f + s1.z) + s0.z, o3 = v[r][j].w * rstd * g.w * (1.f + s1.w) + s0.w;
                u32x2 o; o.x = pk2(o0, o1); o.y = pk2(o2, o3);
                *(u32x2*)(h + (size_t)row * D + k) = o;
            }
        }
    }
}

template <class ARow, class Epi>
DEV void wave_gemm64(const ARow& arow, const bf16* Bt, int K, int m0, int n0, const Epi& epi, int lane) {
    const int r = lane & 31, hh = lane >> 5;
    const bf16* a0 = arow(m0 + r) + 8 * hh; const bf16* a1 = arow(m0 + 32 + r) + 8 * hh;
    const bf16* b0 = Bt + (size_t)(n0 + r) * K + 8 * hh; const bf16* b1 = Bt + (size_t)(n0 + 32 + r) * K + 8 * hh;
    f32x16 c00 = {}, c01 = {}, c10 = {}, c11 = {};
    for (int k = 0; k < K; k += 16) {
        const bf16x8 fa0 = *(const bf16x8*)(a0 + k), fa1 = *(const bf16x8*)(a1 + k), fb0 = *(const bf16x8*)(b0 + k), fb1 = *(const bf16x8*)(b1 + k);
        c00 = __builtin_amdgcn_mfma_f32_32x32x16_bf16(fa0, fb0, c00, 0, 0, 0);
        c01 = __builtin_amdgcn_mfma_f32_32x32x16_bf16(fa0, fb1, c01, 0, 0, 0);
        c10 = __builtin_amdgcn_mfma_f32_32x32x16_bf16(fa1, fb0, c10, 0, 0, 0);
        c11 = __builtin_amdgcn_mfma_f32_32x32x16_bf16(fa1, fb1, c11, 0, 0, 0);
    }
#pragma unroll
    for (int g = 0; g < 16; ++g) {
        const int rr = (g & 3) + 8 * (g >> 2) + 4 * hh;
        epi(m0 + rr, n0 + r, c00[g]); epi(m0 + rr, n0 + 32 + r, c01[g]);
        epi(m0 + 32 + rr, n0 + r, c10[g]); epi(m0 + 32 + rr, n0 + 32 + r, c11[g]);
    }
}


namespace pg8 {
constexpr int BM = 256, BK = 64, HALF = 128, HTB = HALF * BK * 2, STAGE_BYTES = 8 * HTB, NXCD = 8, WGM = 8;
DEV int lds_byte(int r, int c) { const int st = (r >> 4) * 2 + (c >> 5), rr = r & 15, cc = c & 31, ob = rr * 64 + cc * 2; return st * 1024 + (ob ^ (((ob >> 9) & 1) << 5)); }
DEV void stage_rc(int b, int& R, int& C) { const int st = b / 1024, sb = b % 1024, swz = sb ^ (((sb >> 9) & 1) << 5); R = (st >> 1) * 16 + swz / 64; C = (st & 1) * 32 + (swz % 64) / 2; }
DEV int perm32(int rho) { const int n = rho >> 4, i = rho & 15; return 8 * (i >> 2) + 4 * n + (i & 3); }
struct Unit { int pm, pn, g; };
struct Ptrs { const char* a0; const char* a1; const char* b0; const char* b1; };
DEV unsigned cvt_pk_bf16(float lo, float hi) { unsigned r; asm volatile("v_cvt_pk_bf16_f32 %0, %1, %2" : "=v"(r) : "v"(lo), "v"(hi)); return r; }

struct StaticOrder {
    int nM, nN, nwg, G, c; const char* A; const char* Bt; int K;
    DEV void init(const bf16* A_, const bf16* Bt_, int M, int N, int K_, int G_, int c_) { nM = M / BM; nN = N / BM; nwg = nM * nN; G = G_; c = c_; A = (const char*)A_; Bt = (const char*)Bt_; K = K_; }
    DEV bool next(int i, Unit& u) const {
        const long L = (long)i * G + c; if (L >= nwg) return false;
        int wgid = (int)L; { const int q = nwg / NXCD, r = nwg % NXCD, xcd = wgid % NXCD, off = wgid / NXCD; wgid = (xcd < r ? xcd * (q + 1) : r * (q + 1) + (xcd - r) * q) + off; }
        const int nig = WGM * nN, gid = wgid / nig, fm = gid * WGM, gsz = (nM - fm) < WGM ? (nM - fm) : WGM;
        u.pm = fm + ((wgid % nig) % gsz); u.pn = (wgid % nig) / gsz; u.g = 0; return true;
    }
    DEV void ptrs(const Unit& u, Ptrs& p) const { const size_t hstep = (size_t)HALF * K * 2;
        p.a0 = A + (size_t)u.pm * 2 * hstep; p.a1 = p.a0 + hstep; p.b0 = Bt + (size_t)u.pn * 2 * hstep; p.b1 = p.b0 + hstep; }
    DEV int arow(const Unit&, int, int R) const { return R; }
};

typedef int v8i __attribute__((ext_vector_type(8)));
typedef int v4i __attribute__((ext_vector_type(4)));
template <class Epi, class Sched, bool ALIGN_EPI, bool GATHER, bool F8 = false>
DEV void gemm_phase(LAS unsigned char* lds, const int KB, const Sched& S, const Epi& E) {
    const int tid = phase_tid(), wid = __builtin_amdgcn_readfirstlane(tid >> 6), lane = tid & 63, wr = wid >> 2, wc = wid & 3, fr = lane & 15, fq = lane >> 4;
    const int nt = KB / (BK * 2);
    int sR[2], sC[2]; unsigned voffB[2];
#pragma unroll
    for (int i = 0; i < 2; ++i) { int R, C; stage_rc(tid * 16 + i * 8192, R, C); const int Rb = Epi::PERM ? ((R & ~31) + perm32(R & 31)) : R;
        sR[i] = R; sC[i] = C; voffB[i] = (unsigned)(Rb * KB + C * 2); }
    const size_t kstep = (size_t)(BK * 2);
    const unsigned ldsw = (unsigned)wid * 1024u;
    const int aoff = lds_byte(wr * 64 + fr, fq * 8), boff = lds_byte(wc * 32 + fr, fq * 8);
    const int a8o0 = lds_byte(wr * 64 + fr, (2 * (fq & 1)) * 8) + (fq >> 1) * 1024;
    const int b8o0 = lds_byte(wc * 32 + fr, (2 * (fq & 1)) * 8) + (fq >> 1) * 1024;
#define PG8_SA(b, h) (((b) * 2 + (h)) * HTB)
#define PG8_SB(b, h) ((4 + (b) * 2 + (h)) * HTB)
#define PG8_STAGE(bufoff, gbase, voff) do { const char* gb_ = (const char*)(gbase); asm volatile("" : "+s"(gb_)); _Pragma("unroll") for (int _i = 0; _i < 2; ++_i) { \
        unsigned vo_ = (voff)[_i]; asm volatile("" : "+v"(vo_)); \
        __builtin_amdgcn_global_load_lds((const unsigned*)(gb_ + vo_), (LAS unsigned*)(lds + (bufoff) + ldsw + _i * 8192), 16, 0, 0); } } while (0)
    LAS unsigned char* abase = lds + (F8 ? a8o0 : aoff); LAS unsigned char* bbase = lds + 4 * HTB + (F8 ? b8o0 : boff);
    asm volatile("" : "+v"(abase), "+v"(bbase));
#define PG8_LDA(dst, b, h) do { _Pragma("unroll") for (int m = 0; m < 4; ++m) { _Pragma("unroll") for (int k = 0; k < 2; ++k) dst[m][k] = *(const LAS bf16x8*)(abase + ((b) * 2 + (h)) * HTB + m * 2048 + k * (F8 ? 16 : 1024)); } } while (0)
#define PG8_LDB(dst, b, h) do { _Pragma("unroll") for (int n = 0; n < 2; ++n) { _Pragma("unroll") for (int k = 0; k < 2; ++k) dst[n][k] = *(const LAS bf16x8*)(bbase + ((b) * 2 + (h)) * HTB + n * 2048 + k * (F8 ? 16 : 1024)); } } while (0)
#define PG8_F8V(lo, hi) __builtin_shufflevector(__builtin_bit_cast(v4i, lo), __builtin_bit_cast(v4i, hi), 0, 1, 2, 3, 4, 5, 6, 7)
#define PG8_MMA(ai, bj, At, Bt) do { __builtin_amdgcn_s_setprio(1); _Pragma("unroll") for (int m = 0; m < 4; ++m) _Pragma("unroll") for (int n = 0; n < 2; ++n) { \
        if (F8) { acc[ai][bj][m][n] = __builtin_amdgcn_mfma_scale_f32_16x16x128_f8f6f4(PG8_F8V(Bt[n][0], Bt[n][1]), PG8_F8V(At[m][0], At[m][1]), acc[ai][bj][m][n], 0, 0, 0, 0x7F7F7F7F, 0, 0x7F7F7F7F); } \
        else { _Pragma("unroll") for (int k = 0; k < 2; ++k) acc[ai][bj][m][n] = __builtin_amdgcn_mfma_f32_16x16x32_bf16(Bt[n][k], At[m][k], acc[ai][bj][m][n], 0, 0, 0); } } \
        if (F8) asm volatile("" :: "v"(acc[ai][bj][0][0]), "v"(acc[ai][bj][0][1]), "v"(acc[ai][bj][1][0]), "v"(acc[ai][bj][1][1]), "v"(acc[ai][bj][2][0]), "v"(acc[ai][bj][2][1]), "v"(acc[ai][bj][3][0]), "v"(acc[ai][bj][3][1]));   \
        __builtin_amdgcn_s_setprio(0); } while (0)
#define PG8_WAIT_V(n) asm volatile("s_waitcnt vmcnt(" #n ")" ::: "memory")
#define PG8_WAIT_L(n) asm volatile("s_waitcnt lgkmcnt(" #n ")" ::: "memory")
#define PG8_BAR __builtin_amdgcn_s_barrier()
#define PG8_SCHED __builtin_amdgcn_sched_barrier(0)
    Unit cur, nxt; int ui = 0;
    if (!S.next(0, cur)) return;
    f32x4 acc[2][2][4][2];
#pragma unroll
    for (int a = 0; a < 2; ++a)
#pragma unroll
        for (int b = 0; b < 2; ++b)
#pragma unroll
            for (int m = 0; m < 4; ++m)
#pragma unroll
                for (int n = 0; n < 2; ++n) acc[a][b][m][n] = (f32x4){0.f, 0.f, 0.f, 0.f};
    bf16x8 At[4][2], B0[2][2], B1[2][2];
    Ptrs cp; S.ptrs(cur, cp);
    unsigned vA0[2], vA1[2];
#pragma unroll
    for (int i = 0; i < 2; ++i) { vA0[i] = (unsigned)(S.arow(cur, 0, sR[i]) * KB + sC[i] * 2); vA1[i] = GATHER ? (unsigned)(S.arow(cur, 1, sR[i]) * KB + sC[i] * 2) : vA0[i]; }
    PG8_STAGE(PG8_SB(0, 0), cp.b0, voffB); PG8_STAGE(PG8_SB(0, 1), cp.b1, voffB); PG8_STAGE(PG8_SA(0, 0), cp.a0, vA0); PG8_STAGE(PG8_SA(0, 1), cp.a1, vA1);
    if (wr == 1) PG8_BAR;
    PG8_WAIT_V(2); PG8_BAR;
    PG8_STAGE(PG8_SB(1, 0), cp.b0 + kstep, voffB); PG8_STAGE(PG8_SA(1, 0), cp.a0 + kstep, vA0); PG8_STAGE(PG8_SB(1, 1), cp.b1 + kstep, voffB);
    PG8_WAIT_V(6); PG8_BAR;
    for (;;) {
        const bool has_next = S.next(ui + 1, nxt);
        Ptrs np = cp;
        if (has_next) S.ptrs(nxt, np);
        for (int t = 0; t < nt; t += 2) {
            const bool last = (t == nt - 2);
            const char* a1h1 = cp.a1 + (size_t)(t + 1) * kstep;
            const char* a2h0 = last ? np.a0 : cp.a0 + (size_t)(t + 2) * kstep; const char* a2h1 = last ? np.a1 : cp.a1 + (size_t)(t + 2) * kstep;
            const char* b2h0 = last ? np.b0 : cp.b0 + (size_t)(t + 2) * kstep; const char* b2h1 = last ? np.b1 : cp.b1 + (size_t)(t + 2) * kstep;
            PG8_LDB(B0, 0, 0); PG8_LDB(B1, 0, 1); PG8_SCHED; PG8_LDA(At, 0, 0); PG8_STAGE(PG8_SA(1, 1), a1h1, vA1);
            PG8_WAIT_V(8); PG8_WAIT_L(0); PG8_BAR; PG8_MMA(0, 0, At, B0); PG8_MMA(0, 1, At, B1); PG8_BAR; PG8_SCHED;
            PG8_LDA(At, 0, 1); PG8_STAGE(PG8_SB(0, 0), b2h0, voffB); PG8_STAGE(PG8_SB(0, 1), b2h1, voffB); PG8_STAGE(PG8_SA(0, 0), a2h0, vA0);
            PG8_WAIT_V(8); PG8_WAIT_L(0); PG8_BAR; PG8_MMA(1, 0, At, B0); PG8_MMA(1, 1, At, B1); PG8_BAR; PG8_SCHED;
            PG8_LDB(B0, 1, 0); PG8_LDB(B1, 1, 1); PG8_SCHED; PG8_LDA(At, 1, 0); PG8_STAGE(PG8_SA(0, 1), a2h1, vA1);
            PG8_WAIT_V(8); PG8_WAIT_L(0); PG8_BAR; PG8_MMA(0, 0, At, B0); PG8_MMA(0, 1, At, B1); PG8_BAR; PG8_SCHED;
            PG8_LDA(At, 1, 1); PG8_STAGE(PG8_SB(1, 0), b2h0 + kstep, voffB); PG8_STAGE(PG8_SB(1, 1), b2h1 + kstep, voffB); PG8_STAGE(PG8_SA(1, 0), a2h0 + kstep, vA0);
            PG8_WAIT_V(8); PG8_WAIT_L(0); PG8_BAR; PG8_MMA(1, 0, At, B0); PG8_MMA(1, 1, At, B1); PG8_BAR; PG8_SCHED;
        }
        if constexpr (ALIGN_EPI) { if (wr == 0) PG8_BAR; }
        E(acc, cur, wr, wc, fr, fq);
        if (!has_next) break;
#pragma unroll
        for (int a = 0; a < 2; ++a)
#pragma unroll
            for (int b = 0; b < 2; ++b)
#pragma unroll
                for (int m = 0; m < 4; ++m)
#pragma unroll
                    for (int n = 0; n < 2; ++n) acc[a][b][m][n] = (f32x4){0.f, 0.f, 0.f, 0.f};
        cur = nxt; cp = np; ++ui;
        if constexpr (ALIGN_EPI) { if (wr == 1) PG8_BAR; }
    }
    PG8_WAIT_V(0);
    if constexpr (!ALIGN_EPI) { if (wr == 0) PG8_BAR; }
    PG8_BAR;
#undef PG8_SA
#undef PG8_SB
#undef PG8_STAGE
#undef PG8_LDA
#undef PG8_LDB
#undef PG8_MMA
#undef PG8_F8V
#undef PG8_WAIT_V
#undef PG8_WAIT_L
#undef PG8_BAR
#undef PG8_SCHED
}

struct EpiBf16 {
    static constexpr bool PERM = true;
    bf16* O; int ldc;
    DEV void operator()(const f32x4 (&acc)[2][2][4][2], const Unit& u, int wr, int wc, int fr, int fq) const {
        const int row0 = u.pm * BM + wr * 64 + fr, col0 = u.pn * BM + wc * 32 + 8 * fq;
#pragma unroll
        for (int ai = 0; ai < 2; ++ai)
#pragma unroll
            for (int m = 0; m < 4; ++m) { bf16* rowp = O + (size_t)(row0 + ai * HALF + m * 16) * ldc + col0;
#pragma unroll
                for (int bj = 0; bj < 2; ++bj) { const f32x4 v0 = acc[ai][bj][m][0], v1 = acc[ai][bj][m][1];
                    u32x4 w; w.x = cvt_pk_bf16(v0[0], v0[1]); w.y = cvt_pk_bf16(v0[2], v0[3]); w.z = cvt_pk_bf16(v1[0], v1[1]); w.w = cvt_pk_bf16(v1[2], v1[3]);
                    *(u32x4*)(rowp + bj * HALF) = w; } }
    }
};
struct EpiInProj {
    static constexpr bool PERM = true;
    bf16* O; const float* gq; const float* gk; LAS float* xch; unsigned char* QK8;
    DEV void operator()(const f32x4 (&acc)[2][2][4][2], const Unit& u, int wr, int wc, int fr, int fq) const {
        const int row0 = u.pm * BM + wr * 64 + fr, col0 = u.pn * BM + wc * 32 + 8 * fq;
        const bool isqk = (u.pn >= 4) && (u.pn < 8);
        float rs[2][4][2];
        float gs[8];
        if (isqk) {
            const bool isq = u.pn < 6; const float* g = (isq ? gq : gk) + (wc & 1) * 32 + 8 * fq; const float sc = isq ? 0.125f * 1.4426950408889634f : 1.f;
#pragma unroll
            for (int i = 0; i < 8; ++i) gs[i] = g[i] * sc;
            const int wid = wr * 4 + wc;
#pragma unroll
            for (int ai = 0; ai < 2; ++ai)
#pragma unroll
                for (int m = 0; m < 4; ++m)
#pragma unroll
                    for (int bj = 0; bj < 2; ++bj) { const f32x4 v0 = acc[ai][bj][m][0], v1 = acc[ai][bj][m][1];
                        float s = (v0[0] * v0[0] + v0[1] * v0[1]) + (v0[2] * v0[2] + v0[3] * v0[3]) + (v1[0] * v1[0] + v1[1] * v1[1]) + (v1[2] * v1[2] + v1[3] * v1[3]);
                        s += __shfl_xor(s, 16); s += __shfl_xor(s, 32);
                        rs[ai][m][bj] = s;
                        if (fq == 0) xch[(wid * 16 + (ai * 4 + m) * 2 + bj) * 16 + fr] = s; }
            asm volatile("s_waitcnt lgkmcnt(0)" ::: "memory"); __builtin_amdgcn_s_barrier(); asm volatile("" ::: "memory");
            const int pw = wr * 4 + (wc ^ 1);
#pragma unroll
            for (int ai = 0; ai < 2; ++ai)
#pragma unroll
                for (int m = 0; m < 4; ++m)
#pragma unroll
                    for (int bj = 0; bj < 2; ++bj) { const float tot = rs[ai][m][bj] + xch[(pw * 16 + (ai * 4 + m) * 2 + bj) * 16 + fr];
                        rs[ai][m][bj] = rsqrtf(tot * (1.f / 64.f) + EPS); }
        }
#pragma unroll
        for (int ai = 0; ai < 2; ++ai)
#pragma unroll
            for (int m = 0; m < 4; ++m) { bf16* rowp = O + (size_t)(row0 + ai * HALF + m * 16) * NPROJ + col0;
#pragma unroll
                for (int bj = 0; bj < 2; ++bj) { f32x4 v0 = acc[ai][bj][m][0], v1 = acc[ai][bj][m][1];
                    if (isqk) { const float r = rs[ai][m][bj];
                        v0[0] *= r * gs[0]; v0[1] *= r * gs[1]; v0[2] *= r * gs[2]; v0[3] *= r * gs[3]; v1[0] *= r * gs[4]; v1[1] *= r * gs[5]; v1[2] *= r * gs[6]; v1[3] *= r * gs[7];
                        u32x2 w8; w8.x = pk4_fp8(v0[0], v0[1], v0[2], v0[3]); w8.y = pk4_fp8(v1[0], v1[1], v1[2], v1[3]);
                        *(u32x2*)(QK8 + (size_t)(row0 + ai * HALF + m * 16) * 1024 + (u.pn - 4) * BM + bj * HALF + wc * 32 + 8 * fq) = w8; }
                    else { u32x4 w; w.x = cvt_pk_bf16(v0[0], v0[1]); w.y = cvt_pk_bf16(v0[2], v0[3]); w.z = cvt_pk_bf16(v1[0], v1[1]); w.w = cvt_pk_bf16(v1[2], v1[3]);
                        *(u32x4*)(rowp + bj * HALF) = w; } } }
    }
};
struct EpiResGate {
    static constexpr bool PERM = true;
    const float* x; bf16* x1; int ld; const float* mod;
    DEV void operator()(const f32x4 (&acc)[2][2][4][2], const Unit& u, int wr, int wc, int fr, int fq) const {
        const int row0 = u.pm * BM + wr * 64 + fr, col0 = u.pn * BM + wc * 32 + 8 * fq;
        const int b = (u.pm * BM) >> 12;
        f32x4 gv[2][2];
#pragma unroll
        for (int bj = 0; bj < 2; ++bj)
#pragma unroll
            for (int n = 0; n < 2; ++n) gv[bj][n] = *(const f32x4*)(mod + b * 6 * D + 2 * D + col0 + bj * HALF + n * 4);
#pragma unroll
        for (int ai = 0; ai < 2; ++ai)
#pragma unroll
            for (int m = 0; m < 4; ++m) { const int row = row0 + ai * HALF + m * 16;
#pragma unroll
                for (int bj = 0; bj < 2; ++bj) { const float* xp = x + (size_t)row * D + col0 + bj * HALF;
                    const f32x4 v0 = *(const f32x4*)xp + gv[bj][0] * acc[ai][bj][m][0], v1 = *(const f32x4*)(xp + 4) + gv[bj][1] * acc[ai][bj][m][1];
                    u32x4 w; w.x = cvt_pk_bf16(v0[0], v0[1]); w.y = cvt_pk_bf16(v0[2], v0[3]); w.z = cvt_pk_bf16(v1[0], v1[1]); w.w = cvt_pk_bf16(v1[2], v1[3]);
                    *(u32x4*)(x1 + (size_t)row * ld + col0 + bj * HALF) = w; }
                if (m == 3) asm volatile("" ::: "memory"); }
    }
};
}


namespace pg8 {
struct MoeUpOrder {
    int e, b, pm, g; const char* h2; const char* w1; const char* w3; const LAS int* rowtab;
    DEV bool next(int i, Unit& u) const { if (i >= 8) return false; u.pm = pm; u.pn = i; u.g = g; return true; }
    DEV void ptrs(const Unit& u, Ptrs& p) const { p.a0 = h2 + (size_t)b * S * D; p.a1 = p.a0;
        const size_t off = ((size_t)e * D + (size_t)u.pn * HALF) * D; p.b0 = w1 + off; p.b1 = w3 + off; }
    DEV int arow(const Unit&, int half, int R) const { return rowtab[half * HALF + R]; }
};
struct EpiSwiGLU {
    static constexpr bool PERM = true;
    unsigned char* H; const LAS float* gval;
    DEV void operator()(const f32x4 (&acc)[2][2][4][2], const Unit& u, int wr, int wc, int fr, int fq) const {
        { const int t2_ = phase_tid(); fr = t2_ & 15; fq = (t2_ & 63) >> 4; }
        const int row0 = u.g * CAP + u.pm * BM + wr * 64 + fr, col0 = u.pn * HALF + wc * 32 + 8 * fq;
#pragma unroll
        for (int ai = 0; ai < 2; ++ai)
#pragma unroll
            for (int m = 0; m < 4; ++m) { const int row = row0 + ai * HALF + m * 16; unsigned char* rowp = H + (size_t)row * D + col0; const float gs = gval[wr * 64 + fr + ai * HALF + m * 16] * 4.f;
                float o[8];
#pragma unroll
                for (int n = 0; n < 2; ++n)
#pragma unroll
                    for (int j = 0; j < 4; ++j) { const float a = acc[ai][0][m][n][j], bb = acc[ai][1][m][n][j]; o[n * 4 + j] = (a * gs) * __builtin_amdgcn_rcpf(1.f + __builtin_amdgcn_exp2f(a * -1.4426950408889634f)) * bb; }
                u32x2 w; w.x = pk4_fp8(o[0], o[1], o[2], o[3]); w.y = pk4_fp8(o[4], o[5], o[6], o[7]);
                *(u32x2*)rowp = w; }
    }
};
struct MoeDownOrder {
    int e, pm, g; const char* hb; const char* w2;
    DEV bool next(int i, Unit& u) const { if (i >= 4) return false; u.pm = pm; u.pn = i; u.g = g; return true; }
    DEV void ptrs(const Unit& u, Ptrs& p) const { const size_t hstep = (size_t)HALF * D;
        p.a0 = hb + ((size_t)g * CAP + (size_t)pm * BM) * D; p.a1 = p.a0 + hstep; p.b0 = w2 + ((size_t)e * D + (size_t)u.pn * BM) * D; p.b1 = p.b0 + hstep; }
    DEV int arow(const Unit&, int, int R) const { return R; }
};
struct EpiScaleRow {
    static constexpr bool PERM = true;
    unsigned char* Y;
    DEV void operator()(const f32x4 (&acc)[2][2][4][2], const Unit& u, int wr, int wc, int fr, int fq) const {
        { const int t2_ = phase_tid(); fr = t2_ & 15; fq = (t2_ & 63) >> 4; }
        const int row0 = u.g * CAP + u.pm * BM + wr * 64 + fr, col0 = u.pn * BM + wc * 32 + 8 * fq;
#pragma unroll
        for (int ai = 0; ai < 2; ++ai)
#pragma unroll
            for (int m = 0; m < 4; ++m) { unsigned char* rowp = Y + (size_t)(row0 + ai * HALF + m * 16) * D + col0;
#pragma unroll
                for (int bj = 0; bj < 2; ++bj) { const f32x4 v0 = acc[ai][bj][m][0] * 8.f, v1 = acc[ai][bj][m][1] * 8.f;
                    u32x2 w; w.x = pk4_fp8(v0[0], v0[1], v0[2], v0[3]); w.y = pk4_fp8(v1[0], v1[1], v1[2], v1[3]);
                    *(u32x2*)(rowp + bj * HALF) = w; } }
    }
};
}

DEV void ph_inproj(const Params& P, int bid, int nb, unsigned char* lds) {
    pg8::StaticOrder S; S.init((const bf16*)(P.ws + WS_H), (const bf16*)(P.ws + WS_WIN), T, NPROJ, D, nb, bid);
    pg8::EpiInProj E{(bf16*)(P.ws + WS_PROJ), P.in[13], P.in[14], (LAS float*)((LAS unsigned char*)lds + LDS_MISC + 2048), P.ws + WS_QK8};
    pg8::gemm_phase<pg8::EpiInProj, pg8::StaticOrder, true, false>((LAS unsigned char*)lds, D * 2, S, E);
}

DEV void ph_qknorm_conv(const Params& P, int bid, int nb, bool probe = false) {
    const int tid = phase_tid(), lane = tid & 63, wave = tid >> 6;
    bf16* proj = (bf16*)(P.ws + WS_PROJ);
    const float* gq = P.in[13]; const float* gk = P.in[14];
    const int grp = lane >> 2, part = lane & 3;
    const bool isq = grp < 8; const float sc = isq ? 0.125f * 1.4426950408889634f : 1.f;
    float gsc[16];
#pragma unroll
    for (int i = 0; i < 16; ++i) gsc[i] = (isq ? gq : gk)[part * 16 + i] * sc;
    const int gw = bid * NWAVE + wave, ngw = nb * NWAVE;
    for (int row0 = gw; row0 < T; row0 += 4 * ngw) {
        u32x4 w[4][2]; bf16* p[4];
#pragma unroll
        for (int r = 0; r < 4; ++r) { const int row = row0 + r * ngw < T ? row0 + r * ngw : row0; p[r] = proj + (size_t)row * NPROJ + 1024 + grp * 64 + part * 16;
            w[r][0] = *(const u32x4*)p[r]; w[r][1] = *(const u32x4*)(p[r] + 8); }
#pragma unroll
        for (int r = 0; r < 4; ++r) {
            if (r > 0 && row0 + r * ngw >= T) break;
            const unsigned ww[8] = {w[r][0].x, w[r][0].y, w[r][0].z, w[r][0].w, w[r][1].x, w[r][1].y, w[r][1].z, w[r][1].w};
            float v[16]; float ss = 0.f;
#pragma unroll
            for (int i = 0; i < 8; ++i) { v[2 * i] = __uint_as_float(ww[i] << 16); v[2 * i + 1] = __uint_as_float(ww[i] & 0xffff0000u); }
#pragma unroll
            for (int i = 0; i < 16; ++i) ss += v[i] * v[i];
            ss += __shfl_xor(ss, 1); ss += __shfl_xor(ss, 2);
            const float rstd = rsqrtf(ss * (1.f / 64.f) + EPS);
            unsigned o[8];
#pragma unroll
            for (int i = 0; i < 8; ++i) o[i] = pk2(v[2 * i] * rstd * gsc[2 * i], v[2 * i + 1] * rstd * gsc[2 * i + 1]);
            bf16* po = probe ? (bf16*)(P.ws + WS_H) + (p[r] - proj) % (32u << 20) : p[r];
            *(u32x4*)po = (u32x4){o[0], o[1], o[2], o[3]}; *(u32x4*)(po + 8) = (u32x4){o[4], o[5], o[6], o[7]};
        }
    }
}

namespace lru {
typedef float f32x4v __attribute__((ext_vector_type(4)));
constexpr int SUB = 64, SPAN = 1024, NSUB = SPAN / SUB, NSPAN = S / SPAN;
constexpr int G_XL = 0;
constexpr int G_XC = 8704;
constexpr int G_XCB = G_XC + 16384;
constexpr int G_SEG = G_XCB + 64 * 72 * 2;
constexpr int G_CIN = G_SEG + 8192;
constexpr int G_CAR = G_CIN + 4096;
constexpr int G_CW = G_CAR + 512;
constexpr int G_BYTES = G_CW + 1280;
static_assert(2 * G_BYTES <= 131072, "LRU LDS");
DEV float gelu_tanh_fast(float x) { const float u = 0.7978845608028654f * (x + 0.044715f * x * x * x); const float e = __expf(2.f * u); return x * (1.f - __builtin_amdgcn_rcpf(e + 1.f)); }

template <int MODE>
DEV void sweep2(const Params& P, unsigned char* lds0, int b, int n, int span, int bid, int nb) {
    const int tid = phase_tid(), lane = tid & 63, wid = __builtin_amdgcn_readfirstlane(tid >> 6);
    const int dir = wid >> 2, lw = wid & 3, lt = tid & 255;
    unsigned char* lds = lds0 + dir * G_BYTES;
    const bf16* proj = (const bf16*)(P.ws + WS_PROJ); bf16* ycat = (bf16*)(P.ws + WS_YCAT);
    float* sum = (float*)(P.ws + WS_LSUM);
    bf16* XL = (bf16*)(lds + G_XL); float* XC = (float*)(lds + G_XC); bf16* XCB = (bf16*)(lds + G_XCB);
    float* SEG = (float*)(lds + G_SEG); float* CIN = (float*)(lds + G_CIN); float* CAR = (float*)(lds + G_CAR); float* CW = (float*)(lds + G_CW);
    const int ch0 = n * 64;
    const int db = lw, fr = lane & 15, fq = lane >> 4;
    bf16x8 Ba[2], Bx[2];
    { const float* wa = P.in[8] + ((size_t)(dir * 8 + n) * 64) * 64 + db * 16 + fr; const float* wx = P.in[10] + ((size_t)(dir * 8 + n) * 64) * 64 + db * 16 + fr;
#pragma unroll
      for (int ks = 0; ks < 2; ++ks) { unsigned pa[4], px[4];
#pragma unroll
          for (int jj = 0; jj < 4; ++jj) { const int c = ks * 32 + fq * 8 + 2 * jj; pa[jj] = pk2(wa[c * 64], wa[(c + 1) * 64]); px[jj] = pk2(wx[c * 64], wx[(c + 1) * 64]); }
          const u32x4 va = {pa[0], pa[1], pa[2], pa[3]}, vx = {px[0], px[1], px[2], px[3]};
          Ba[ks] = *reinterpret_cast<const bf16x8*>(&va); Bx[ks] = *reinterpret_cast<const bf16x8*>(&vx); } }
    const int cl = db * 16 + fr;
    const int gch = dir * DL + ch0 + cl;
    const float ba = P.in[9][gch], bx = P.in[11][gch];
    float ls; { const float l = P.in[12][gch]; ls = 8.0f * (fminf(l, 0.f) - log1pf(__expf(-fabsf(l)))); }
    const float ls2 = ls * 1.4426950408889634f, nba = -ba * 1.4426950408889634f, nbx = -bx * 1.4426950408889634f;
    __syncthreads();
    CW[lt] = P.in[6][(lt >> 6) * DL + ch0 + (lt & 63)];
    if (lt < 64) {
        CW[256 + lt] = P.in[7][ch0 + lt];
        if (MODE == 1) { float h = 0.f; const float* sp = sum + ((size_t)(b * 2 + dir) * NSPAN) * DL * 2 + (size_t)(ch0 + lt) * 2;
            float2 m4[NSPAN];
#pragma unroll
            for (int s2 = 0; s2 < NSPAN; ++s2) m4[s2] = *(const float2*)(sp + (size_t)s2 * DL * 2);
            if (dir == 0) {
#pragma unroll
                for (int s2 = 0; s2 < NSPAN; ++s2) h = s2 < span ? m4[s2].x * h + m4[s2].y : h;
            } else {
#pragma unroll
                for (int s2 = NSPAN - 1; s2 >= 0; --s2) h = s2 > span ? m4[s2].x * h + m4[s2].y : h;
            }
            CAR[2 * lt + 1] = h; }
    }
    u32x4 xp[3];
    bf16* xcg = (bf16*)(P.ws + WS_XCG);
#define XL_LOAD(kx) do { const int t0_ = span * SPAN + (kx) * SUB; \
        if (MODE == 0) { _Pragma("unroll") for (int q_ = 0; q_ < 3; ++q_) { const int p_ = q_ * 256 + lt; xp[q_] = (u32x4){0u, 0u, 0u, 0u}; \
            if (p_ < 67 * 8) { const int t = t0_ - 2 + (p_ >> 3); if (t >= 0 && t < S) xp[q_] = *(const u32x4*)(proj + ((size_t)b * S + t) * NPROJ + ch0 + (p_ & 7) * 8); } } } \
        else { _Pragma("unroll") for (int q_ = 0; q_ < 2; ++q_) { const int p_ = q_ * 256 + lt; xp[q_] = *(const u32x4*)(xcg + ((size_t)b * S + t0_ + (p_ >> 3)) * DL + ch0 + (p_ & 7) * 8); } } } while (0)
    XL_LOAD(dir == 0 ? 0 : NSUB - 1);
    const int pgw = bid * NWAVE + wid, pngw = nb * NWAVE;
    float Ar = 1.f, Hr = 0.f, hrun = 0.f;
    for (int kk = 0; kk < NSUB; ++kk) {
        const int k = dir == 0 ? kk : NSUB - 1 - kk;
        const int t0 = span * SPAN + k * SUB;
        const size_t row0 = (size_t)b * S + t0;
        Prep2Item pit; float ptv[32]; bool phas = false;
        if (MODE == 0) { phas = prep2_decode(P, pgw + kk * pngw, pit); if (phas) prep2_load(pit, lane, ptv); }
        if (MODE == 0) {
#pragma unroll
            for (int q = 0; q < 3; ++q) { const int p = q * 256 + lt; if (p < 67 * 8) *(u32x4*)(XL + (p >> 3) * 64 + (p & 7) * 8) = xp[q]; }
        } else {
#pragma unroll
            for (int q = 0; q < 2; ++q) { const int p = q * 256 + lt; *(u32x4*)(XCB + (p >> 3) * 72 + (p & 7) * 8) = xp[q]; }
        }
        if (kk + 1 < NSUB) XL_LOAD(dir == 0 ? kk + 1 : NSUB - 2 - kk);
        __syncthreads();
        const bool second = (MODE == 1) && (kk >= NSUB / 2);
        u32x4 pk_h[2], pk_z[2];
        if (second) { const int t = lt >> 2, c16 = (lt & 3) * 16;
            pk_h[0] = *(const u32x4*)(ycat + (row0 + t) * D + ch0 + c16); pk_h[1] = *(const u32x4*)(ycat + (row0 + t) * D + ch0 + c16 + 8);
            pk_z[0] = *(const u32x4*)(proj + (row0 + t) * NPROJ + 512 + ch0 + c16); pk_z[1] = *(const u32x4*)(proj + (row0 + t) * NPROJ + 512 + ch0 + c16 + 8); }
        if (MODE == 0) {
        { const int t = lt >> 2, c16 = (lt & 3) * 16; float acc[16];
#pragma unroll
          for (int i = 0; i < 16; i += 4) { const f32x4v cb4 = *(const f32x4v*)(CW + 256 + c16 + i); acc[i] = cb4.x; acc[i + 1] = cb4.y; acc[i + 2] = cb4.z; acc[i + 3] = cb4.w; }
#pragma unroll
          for (int w = 0; w < 4; ++w) {
#pragma unroll
              for (int hlf = 0; hlf < 2; ++hlf) { const u32x4 xv = *(const u32x4*)(XL + (t + w) * 64 + c16 + hlf * 8); const unsigned xw[4] = {xv.x, xv.y, xv.z, xv.w};
                  const f32x4v w0 = *(const f32x4v*)(CW + w * 64 + c16 + hlf * 8), w1 = *(const f32x4v*)(CW + w * 64 + c16 + hlf * 8 + 4);
                  const float wv[8] = {w0.x, w0.y, w0.z, w0.w, w1.x, w1.y, w1.z, w1.w};
#pragma unroll
                  for (int i = 0; i < 4; ++i) { acc[hlf * 8 + 2 * i] += wv[2 * i] * __uint_as_float(xw[i] << 16); acc[hlf * 8 + 2 * i + 1] += wv[2 * i + 1] * __uint_as_float(xw[i] & 0xffff0000u); } } }
          const u32x4 o0 = {pk2(acc[0], acc[1]), pk2(acc[2], acc[3]), pk2(acc[4], acc[5]), pk2(acc[6], acc[7])}, o1 = {pk2(acc[8], acc[9]), pk2(acc[10], acc[11]), pk2(acc[12], acc[13]), pk2(acc[14], acc[15])};
          *(u32x4*)(XCB + t * 72 + c16) = o0; *(u32x4*)(XCB + t * 72 + c16 + 8) = o1;
          if (dir == (k < NSUB / 2 ? 0 : 1)) { bf16* gp = xcg + (row0 + t) * DL + ch0 + c16; *(u32x4*)gp = o0; *(u32x4*)(gp + 8) = o1; } }
        __syncthreads();
        }
        if (MODE == 1 && kk == 0) hrun = CAR[2 * cl + 1];
        float av[16], uv[16], EA[4], EH[4], TA[4], TH[4];
        const bool first = (dir == 0) ? !(fq & 1) : (fq & 1), firstpair = (dir == 0) ? !(fq & 2) : ((fq & 2) != 0);
#pragma unroll
        for (int tb = 0; tb < 4; ++tb) {
            f32x4v ga = {0.f, 0.f, 0.f, 0.f}, gx = {0.f, 0.f, 0.f, 0.f};
#pragma unroll
            for (int ks = 0; ks < 2; ++ks) { const bf16x8 af = *(const bf16x8*)(XCB + (tb * 16 + fr) * 72 + ks * 32 + fq * 8);
                ga = __builtin_amdgcn_mfma_f32_16x16x32_bf16(af, Ba[ks], ga, 0, 0, 0); gx = __builtin_amdgcn_mfma_f32_16x16x32_bf16(af, Bx[ks], gx, 0, 0, 0); }
#pragma unroll
            for (int rg = 0; rg < 4; ++rg) { const int t = tb * 16 + fq * 4 + rg;
                const float r = __builtin_amdgcn_rcpf(1.f + __builtin_amdgcn_exp2f(__builtin_fmaf(ga[rg], -1.4426950408889634f, nba)));
                const float ig = __builtin_amdgcn_rcpf(1.f + __builtin_amdgcn_exp2f(__builtin_fmaf(gx[rg], -1.4426950408889634f, nbx)));
                const float a = __builtin_amdgcn_exp2f(r * ls2); av[tb * 4 + rg] = a;
                uv[tb * 4 + rg] = __builtin_amdgcn_sqrtf(fmaxf(__builtin_fmaf(-a, a, 1.f), 0.f)) * (ig * bf2f(XCB[t * 72 + cl])); }
            float A = 1.f, H = 0.f;
            if (dir == 0) {
#pragma unroll
                for (int i = 0; i < 4; ++i) { H = av[tb * 4 + i] * H + uv[tb * 4 + i]; A *= av[tb * 4 + i]; }
            } else {
#pragma unroll
                for (int i = 3; i >= 0; --i) { H = av[tb * 4 + i] * H + uv[tb * 4 + i]; A *= av[tb * 4 + i]; }
            }
            const float oA = __shfl_xor(A, 16), oH = __shfl_xor(H, 16);
            const float PA = A * oA, PH = first ? (oA * H + oH) : (A * oH + H);
            const float QA = __shfl_xor(PA, 32), QH = __shfl_xor(PH, 32);
            TA[tb] = PA * QA; TH[tb] = firstpair ? (QA * PH + QH) : (PA * QH + PH);
            const float XA = first ? 1.f : oA, XH = first ? 0.f : oH, YA = firstpair ? 1.f : QA, YH = firstpair ? 0.f : QH;
            EA[tb] = XA * YA; EH[tb] = XA * YH + XH;
        }
        if (MODE == 0) {
            if (dir == 0) {
#pragma unroll
                for (int tb = 0; tb < 4; ++tb) { Hr = TA[tb] * Hr + TH[tb]; Ar *= TA[tb]; }
            } else {
#pragma unroll
                for (int tb = 3; tb >= 0; --tb) { Hr = TA[tb] * Hr + TH[tb]; Ar *= TA[tb]; }
            }
        }
        if (MODE == 0) { if (phas) prep2_finish(pit, lane, ptv); }
        if (MODE == 1) {
            if (dir == 0) {
#pragma unroll
                for (int tb = 0; tb < 4; ++tb) { float h = EA[tb] * hrun + EH[tb]; hrun = TA[tb] * hrun + TH[tb]; float hv[4];
#pragma unroll
                    for (int i = 0; i < 4; ++i) { h = av[tb * 4 + i] * h + uv[tb * 4 + i]; hv[i] = h; }
#pragma unroll
                    for (int rg = 0; rg < 4; ++rg) XC[(tb * 16 + fq * 4 + rg) * 64 + cl] = hv[rg]; }
            } else {
#pragma unroll
                for (int tb = 3; tb >= 0; --tb) { float h = EA[tb] * hrun + EH[tb]; hrun = TA[tb] * hrun + TH[tb]; float hv[4];
#pragma unroll
                    for (int i = 3; i >= 0; --i) { h = av[tb * 4 + i] * h + uv[tb * 4 + i]; hv[i] = h; }
#pragma unroll
                    for (int rg = 0; rg < 4; ++rg) XC[(tb * 16 + fq * 4 + rg) * 64 + cl] = hv[rg]; }
            }
            __syncthreads();
            { const int t = lt >> 2, c16 = (lt & 3) * 16; float hh[16];
#pragma unroll
              for (int i = 0; i < 16; i += 4) { const f32x4v v4 = *(const f32x4v*)(XC + t * 64 + c16 + i); hh[i] = v4.x; hh[i + 1] = v4.y; hh[i + 2] = v4.z; hh[i + 3] = v4.w; }
              if (second) { const unsigned ph[8] = {pk_h[0].x, pk_h[0].y, pk_h[0].z, pk_h[0].w, pk_h[1].x, pk_h[1].y, pk_h[1].z, pk_h[1].w};
                  const unsigned pz[8] = {pk_z[0].x, pk_z[0].y, pk_z[0].z, pk_z[0].w, pk_z[1].x, pk_z[1].y, pk_z[1].z, pk_z[1].w};
#pragma unroll
                  for (int i = 0; i < 8; ++i) { hh[2 * i] = (hh[2 * i] + __uint_as_float(ph[i] << 16)) * gelu_tanh_fast(__uint_as_float(pz[i] << 16));
                      hh[2 * i + 1] = (hh[2 * i + 1] + __uint_as_float(ph[i] & 0xffff0000u)) * gelu_tanh_fast(__uint_as_float(pz[i] & 0xffff0000u)); } }
              bf16* yp = ycat + (row0 + t) * D + ch0 + c16;
              *(u32x4*)yp = (u32x4){pk2(hh[0], hh[1]), pk2(hh[2], hh[3]), pk2(hh[4], hh[5]), pk2(hh[6], hh[7])};
              *(u32x4*)(yp + 8) = (u32x4){pk2(hh[8], hh[9]), pk2(hh[10], hh[11]), pk2(hh[12], hh[13]), pk2(hh[14], hh[15])}; }
        }
    }
#undef XL_LOAD
    if (MODE == 0 && fq == 0) { float* sp = sum + (((size_t)(b * 2 + dir) * NSPAN + span) * DL + ch0 + cl) * 2; sp[0] = Ar; sp[1] = Hr; }
}
}

DEV void ph_lru_pass(const Params& P, int bid, int nb, unsigned char* lds, int mode) {
    const int vcu = (bid % 8) * (nb / 8) + bid / 8;
    const int b = vcu >> 5, n = (vcu >> 2) & 7, span = vcu & 3;
    if (mode == 0) lru::sweep2<0>(P, lds, b, n, span, bid, nb); else lru::sweep2<1>(P, lds, b, n, span, bid, nb);
}

namespace att {
typedef short s16x4 __attribute__((ext_vector_type(4)));
constexpr int KVBLK = 64, QBLK = 32, UROWS = 128;
constexpr int SHM_V = KVBLK * 128 * 2, SHM_K = KVBLK * 128 * 2;
constexpr int NVB = 3;
constexpr int LDS_WS = NVB * SHM_V + 2 * SHM_K;
constexpr int LDS_TAB = LDS_WS + 8 * 64 * 4;
constexpr int LDS_STG = LDS_TAB + 4 * 384 * 4;
constexpr int TABN = 384, TABOFF = 192;
constexpr float LOG2E = 1.4426950408889634f;
#define KSWZ(row, colB) ((row) * 256 + ((colB) ^ (((row) & 15) << 4)))
#define SBAR() __builtin_amdgcn_sched_barrier(0)
DEV int crow(int r, int hi) { return (r & 3) + 8 * (r >> 2) + 4 * hi; }
DEV unsigned cvtpk(float lo, float hi) { unsigned r; asm volatile("v_cvt_pk_bf16_f32 %0, %1, %2" : "=v"(r) : "v"(lo), "v"(hi)); return r; }
DEV void exp_half(f32x16& p) {
#pragma unroll
    for (int r = 0; r < 16; ++r) p[r] = __builtin_amdgcn_exp2f(p[r]);
}
DEV void finishSM(f32x16& p0, f32x16& p1, float& l_reg, bf16x8& pa0, bf16x8& pa1, bf16x8& pa2, bf16x8& pa3) {
    exp_half(p1);
    float ps = 0.f;
#pragma unroll
    for (int r = 0; r < 16; ++r) ps += p0[r];
#pragma unroll
    for (int r = 0; r < 16; ++r) ps += p1[r];
    l_reg += ps;
#define PK4(P, BASE, OUT) do { unsigned a0 = cvtpk(P[BASE + 0], P[BASE + 1]), a1 = cvtpk(P[BASE + 2], P[BASE + 3]);   \
    unsigned b0 = cvtpk(P[BASE + 4], P[BASE + 5]), b1 = cvtpk(P[BASE + 6], P[BASE + 7]);                              \
    auto r0 = __builtin_amdgcn_permlane32_swap(a0, b0, false, false); auto r1 = __builtin_amdgcn_permlane32_swap(a1, b1, false, false); \
    u32x4 w = {r0[0], r1[0], r0[1], r1[1]}; OUT = *reinterpret_cast<bf16x8*>(&w); } while (0)
    PK4(p0, 0, pa0); PK4(p0, 8, pa1); PK4(p1, 0, pa2); PK4(p1, 8, pa3);
#undef PK4
}
typedef int v8i __attribute__((ext_vector_type(8)));
typedef int v4i __attribute__((ext_vector_type(4)));
DEV int k8_off(int row, int chunk) { return row * 128 + ((chunk ^ ((row >> 1) & 7)) << 4); }
DEV void qkt(f32x16& p0, f32x16& p1, const char* Ks, const v8i& qf, int r32, int hi, int j, int base, const float* tl) {
    const bool nearT = (base > -154) && (base < 122);
    const int c0 = j * 4 + hi * 2;
    const v4i a00 = *reinterpret_cast<const v4i*>(Ks + k8_off(r32, c0)), a01 = *reinterpret_cast<const v4i*>(Ks + k8_off(r32, c0 + 1));
    const v4i a10 = *reinterpret_cast<const v4i*>(Ks + 4096 + k8_off(r32, c0)), a11 = *reinterpret_cast<const v4i*>(Ks + 4096 + k8_off(r32, c0 + 1));
    const v8i ka = __builtin_shufflevector(a00, a01, 0, 1, 2, 3, 4, 5, 6, 7), kb = __builtin_shufflevector(a10, a11, 0, 1, 2, 3, 4, 5, 6, 7);
    if (nearT) {
        const float* t = tl + (base - r32 + TABOFF + 4 * hi);
#pragma unroll
        for (int r = 0; r < 16; ++r) { const int ko = (r & 3) + 8 * (r >> 2); p0[r] = t[ko]; p1[r] = t[32 + ko]; }
        p0 = __builtin_amdgcn_mfma_scale_f32_32x32x64_f8f6f4(ka, qf, p0, 0, 0, 0, 0x7F7F7F7F, 0, 0x7F7F7F7F);
        p1 = __builtin_amdgcn_mfma_scale_f32_32x32x64_f8f6f4(kb, qf, p1, 0, 0, 0, 0x7F7F7F7F, 0, 0x7F7F7F7F);
    } else {
        p0 = __builtin_amdgcn_mfma_scale_f32_32x32x64_f8f6f4(ka, qf, (f32x16){}, 0, 0, 0, 0x7F7F7F7F, 0, 0x7F7F7F7F);
        p1 = __builtin_amdgcn_mfma_scale_f32_32x32x64_f8f6f4(kb, qf, (f32x16){}, 0, 0, 0, 0x7F7F7F7F, 0, 0x7F7F7F7F);
    }
}
DEV int v_st(int k, int c) { const int kk = (k & ~0xC) | ((k & 4) << 1) | ((k & 8) >> 1); return ((kk >> 3) * 4 + (c >> 5)) * 512 + ((kk & 7) * 32 + (c & 31)) * 2; }
DEV int v_rd_base(int lane) { return ((lane & 3) << 3) | (((lane >> 2) & 3) << 6) | (((lane >> 4) & 1) << 5) | (((lane >> 5) & 1) << 8); }
constexpr int v_rd_off(int d0, int ks, int half) { return d0 * 512 + ks * 4096 + half * 2048; }
template <int OFF> DEV s16x4 tr_read(int vb) { s16x4 r; asm volatile("ds_read_b64_tr_b16 %0, %1 offset:%2" : "=&v"(r) : "v"(vb), "i"(OFF) : "memory"); return r; }
template <int D0> DEV void pv_one(f32x16& od, int vb, bf16x8 pa0, bf16x8 pa1, bf16x8 pa2, bf16x8 pa3) {
    const s16x4 l0 = tr_read<v_rd_off(D0, 0, 0)>(vb), h0 = tr_read<v_rd_off(D0, 0, 1)>(vb), l1 = tr_read<v_rd_off(D0, 1, 0)>(vb), h1 = tr_read<v_rd_off(D0, 1, 1)>(vb);
    const s16x4 l2 = tr_read<v_rd_off(D0, 2, 0)>(vb), h2 = tr_read<v_rd_off(D0, 2, 1)>(vb), l3 = tr_read<v_rd_off(D0, 3, 0)>(vb), h3 = tr_read<v_rd_off(D0, 3, 1)>(vb);
    asm volatile("s_waitcnt lgkmcnt(0)" ::: "memory"); SBAR();
#define PK(L, H) (bf16x8){L[0], L[1], L[2], L[3], H[0], H[1], H[2], H[3]}
    od = __builtin_amdgcn_mfma_f32_32x32x16_bf16(pa0, PK(l0, h0), od, 0, 0, 0);
    od = __builtin_amdgcn_mfma_f32_32x32x16_bf16(pa1, PK(l1, h1), od, 0, 0, 0);
    od = __builtin_amdgcn_mfma_f32_32x32x16_bf16(pa2, PK(l2, h2), od, 0, 0, 0);
    od = __builtin_amdgcn_mfma_f32_32x32x16_bf16(pa3, PK(l3, h3), od, 0, 0, 0);
#undef PK
}
DEV void pv_d0(f32x16* o, int vb, bf16x8 pa0, bf16x8 pa1, bf16x8 pa2, bf16x8 pa3) {
    pv_one<0>(o[0], vb, pa0, pa1, pa2, pa3); pv_one<1>(o[1], vb, pa0, pa1, pa2, pa3); pv_one<2>(o[2], vb, pa0, pa1, pa2, pa3); pv_one<3>(o[3], vb, pa0, pa1, pa2, pa3);
}

DEV void attn_unit(const bf16* __restrict__ proj, const unsigned char* __restrict__ qk8, bf16* __restrict__ ycat, int b, int h, int ublk, char* lds, float fsw, float lamv, const float* __restrict__ go) {
    const int tid = phase_tid(), wid = __builtin_amdgcn_readfirstlane(tid >> 6), lane = tid & 63, r32 = lane & 31, hi = lane >> 5;
    const int qb = wid >> 1, j = wid & 1, jcb = j * 128;
    char* V_lds = lds; char* K_lds = lds + NVB * SHM_V;
    float* wsf = (float*)(lds + LDS_WS) + wid * 64;
    const float* tl = (const float*)(lds + LDS_TAB) + h * TABN;
    const long rowbase = (long)b * S;
    const int q0w = ublk * UROWS + qb * QBLK;
    float l_reg = 0.f; f32x16 o[4] = {}; v8i qr;
    { const unsigned char* Qw = qk8 + (size_t)(rowbase + q0w + r32) * 1024 + h * 128 + j * 64 + hi * 32;
      const v4i q0 = *reinterpret_cast<const v4i*>(Qw), q1 = *reinterpret_cast<const v4i*>(Qw + 16); qr = __builtin_shufflevector(q0, q1, 0, 1, 2, 3, 4, 5, 6, 7); }
    const unsigned char* Kh = qk8 + (size_t)rowbase * 1024 + 512 + h * 128; const bf16* Vh = proj + rowbase * NPROJ + 2048 + h * 128;
    const int kkey = tid >> 3, kch = tid & 7, kst = k8_off(kkey, kch);
    const int sr = tid >> 4, sc = (tid & 15) * 8, vst0 = v_st(sr, sc), vst1 = v_st(32 + sr, sc);
    const int vb0 = (int)(uintptr_t)V_lds + v_rd_base(lane);
    struct { bf16x8 vs0, vs1; v4i ks; } sr_[2];
#define SLOAD(i, k0) do { sr_[i].vs0 = *reinterpret_cast<const bf16x8*>(&Vh[(long)((k0) + sr) * NPROJ + sc]); sr_[i].vs1 = *reinterpret_cast<const bf16x8*>(&Vh[(long)((k0) + 32 + sr) * NPROJ + sc]); \
    sr_[i].ks = *reinterpret_cast<const v4i*>(Kh + (size_t)((k0) + kkey) * 1024 + kch * 16); } while (0)
#define SWRITE(kb, vbo, i) do { *(bf16x8*)(V_lds + (vbo) + vst0) = sr_[i].vs0; *(bf16x8*)(V_lds + (vbo) + vst1) = sr_[i].vs1; *(v4i*)(K_lds + (kb) * SHM_K + kst) = sr_[i].ks; } while (0)
#define SWAIT() asm volatile("s_waitcnt vmcnt(3)" ::: "memory")
    bool switched = false, pend = false;
#define CCUPD(base) do { if (!switched && (base) >= 122) { switched = true; pend = true; } } while (0)
#define RESCALE() do { if (pend) { pend = false; l_reg *= fsw; _Pragma("unroll") for (int d = 0; d < 4; ++d) _Pragma("unroll") for (int r = 0; r < 16; ++r) o[d][r] *= fsw; } } while (0)
    bf16x8 pa0, pa1, pa2, pa3; constexpr int NT = S / KVBLK;
    constexpr int SE = 0, SO = 1;
    int vrd = 0, vcur = SHM_V, vwr = 2 * SHM_V;
#define VROT() do { const int t_ = vrd; vrd = vcur; vcur = vwr; vwr = t_; } while (0)
    if (wid < 4) {
    f32x16 pA0, pA1, pB0, pB1;
    SLOAD(SE, 0); asm volatile("s_waitcnt vmcnt(0)" ::: "memory"); SWRITE(0, 0, SE); __syncthreads();
    { const int base = 0 - q0w; CCUPD(base); qkt(pA0, pA1, K_lds, qr, r32, hi, j, base, tl); } exp_half(pA0);
    SLOAD(SO, KVBLK); SLOAD(SE, 2 * KVBLK);
    SWAIT(); SWRITE(1, SHM_V, SO); __syncthreads();
    for (int jt = 1; jt + 1 < NT; jt += 2) {
        SBAR(); { const int base = jt * KVBLK - q0w; CCUPD(base); qkt(pB0, pB1, K_lds + SHM_K, qr, r32, hi, j, base, tl); }
        finishSM(pA0, pA1, l_reg, pa0, pa1, pa2, pa3); SBAR();
        SLOAD(SO, (jt + 2) * KVBLK); SBAR();
        pv_d0(o, vb0 + vrd, pa0, pa1, pa2, pa3); exp_half(pB0); RESCALE();
        SWAIT(); SWRITE(0, vwr, SE);
        __syncthreads(); VROT();
        SBAR(); { const int base = (jt + 1) * KVBLK - q0w; CCUPD(base); qkt(pA0, pA1, K_lds, qr, r32, hi, j, base, tl); }
        finishSM(pB0, pB1, l_reg, pa0, pa1, pa2, pa3); SBAR();
        if (jt + 3 < NT) SLOAD(SE, (jt + 3) * KVBLK); SBAR();
        pv_d0(o, vb0 + vrd, pa0, pa1, pa2, pa3); exp_half(pA0); RESCALE();
        SWAIT(); SWRITE(1, vwr, SO);
        __syncthreads(); VROT();
    }
    SBAR(); { const int base = (NT - 1) * KVBLK - q0w; CCUPD(base); qkt(pB0, pB1, K_lds + SHM_K, qr, r32, hi, j, base, tl); }
    finishSM(pA0, pA1, l_reg, pa0, pa1, pa2, pa3); SBAR();
    pv_d0(o, vb0 + vrd, pa0, pa1, pa2, pa3); exp_half(pB0); RESCALE();
    finishSM(pB0, pB1, l_reg, pa0, pa1, pa2, pa3); SBAR();
    pv_d0(o, vb0 + vcur, pa0, pa1, pa2, pa3);
    } else {
    f32x16 pC0, pC1;
#define RESC_NOW(base) do { if (!switched && (base) >= 122) { switched = true; l_reg *= fsw; _Pragma("unroll") for (int d = 0; d < 4; ++d) _Pragma("unroll") for (int r = 0; r < 16; ++r) o[d][r] *= fsw; } } while (0)
    SLOAD(SE, 0); asm volatile("s_waitcnt vmcnt(0)" ::: "memory"); SWRITE(0, 0, SE); __syncthreads();
    { const int base = 0 - q0w; qkt(pC0, pC1, K_lds, qr, r32, hi, j, base, tl); } exp_half(pC0); finishSM(pC0, pC1, l_reg, pa0, pa1, pa2, pa3);
    SLOAD(SO, KVBLK); SLOAD(SE, 2 * KVBLK);
    SWAIT(); SWRITE(1, SHM_V, SO); __syncthreads();
    for (int jt = 1; jt + 1 < NT; jt += 2) {
        SBAR(); SLOAD(SO, (jt + 2) * KVBLK); SBAR();
        pv_d0(o, vb0 + vrd, pa0, pa1, pa2, pa3);
        { const int base = jt * KVBLK - q0w; RESC_NOW(base); SBAR(); qkt(pC0, pC1, K_lds + SHM_K, qr, r32, hi, j, base, tl); }
        exp_half(pC0); finishSM(pC0, pC1, l_reg, pa0, pa1, pa2, pa3); SBAR();
        SWAIT(); SWRITE(0, vwr, SE);
        __syncthreads(); VROT();
        SBAR(); if (jt + 3 < NT) SLOAD(SE, (jt + 3) * KVBLK); SBAR();
        pv_d0(o, vb0 + vrd, pa0, pa1, pa2, pa3);
        { const int base = (jt + 1) * KVBLK - q0w; RESC_NOW(base); SBAR(); qkt(pC0, pC1, K_lds, qr, r32, hi, j, base, tl); }
        exp_half(pC0); finishSM(pC0, pC1, l_reg, pa0, pa1, pa2, pa3); SBAR();
        SWAIT(); SWRITE(1, vwr, SO);
        __syncthreads(); VROT();
    }
    pv_d0(o, vb0 + vrd, pa0, pa1, pa2, pa3);
    { const int base = (NT - 1) * KVBLK - q0w; RESC_NOW(base); SBAR(); qkt(pC0, pC1, K_lds + SHM_K, qr, r32, hi, j, base, tl); }
    exp_half(pC0); finishSM(pC0, pC1, l_reg, pa0, pa1, pa2, pa3); SBAR();
    pv_d0(o, vb0 + vcur, pa0, pa1, pa2, pa3);
#undef RESC_NOW
    }
#undef VROT
#undef SLOAD
#undef SWRITE
#undef SWAIT
#undef CCUPD
#undef RESCALE
    { auto rr = __builtin_amdgcn_permlane32_swap(__float_as_uint(l_reg), __float_as_uint(l_reg), false, false); l_reg = __uint_as_float(rr[0]) + __uint_as_float(rr[1]); }
    if (hi == 0) wsf[r32] = l_reg;
    asm volatile("s_waitcnt lgkmcnt(0)" ::: "memory");
    __syncthreads();
    float* X = (float*)lds + qb * 4096;
    if (j == 1) {
#pragma unroll
        for (int r = 0; r < 16; ++r) { const float sc = __builtin_amdgcn_rcpf(wsf[crow(r, hi)]) * lamv;
#pragma unroll
            for (int d0 = 0; d0 < 4; ++d0) X[(d0 * 16 + r) * 64 + lane] = o[d0][r] * sc;
            asm volatile("" ::: "memory"); }
    }
    __syncthreads();
    if (j == 0) {
        float gv[4];
#pragma unroll
        for (int d0 = 0; d0 < 4; ++d0) gv[d0] = go[32 * d0 + r32] * (1.f - LAM_INIT);
        bf16* stg = (bf16*)(lds + LDS_STG) + qb * 4096;
#pragma unroll
        for (int r = 0; r < 16; ++r) {
            const float ri = __builtin_amdgcn_rcpf(wsf[crow(r, hi)]);
            float v[4]; float ss = 0.f;
#pragma unroll
            for (int d0 = 0; d0 < 4; ++d0) { v[d0] = o[d0][r] * ri - X[(d0 * 16 + r) * 64 + lane]; ss += v[d0] * v[d0]; }
            ss += __shfl_xor(ss, 1); ss += __shfl_xor(ss, 2); ss += __shfl_xor(ss, 4); ss += __shfl_xor(ss, 8); ss += __shfl_xor(ss, 16);
            const float rs = rsqrtf(ss * (1.f / 128.f) + EPS);
            const int q = crow(r, hi);
#pragma unroll
            for (int d0 = 0; d0 < 4; ++d0) stg[q * 128 + d0 * 32 + r32] = (bf16)f2bf(v[d0] * rs * gv[d0]);
            asm volatile("" ::: "memory");
        }
        asm volatile("s_waitcnt lgkmcnt(0)" ::: "memory");
        bf16* Ow = ycat + (rowbase + q0w) * D + 512 + h * 128;
#pragma unroll
        for (int i = 0; i < 8; ++i) { const int row = i * 4 + (lane >> 4), ch = lane & 15;
            const u32x4 v = *(const u32x4*)(stg + row * 128 + ch * 8); *(u32x4*)(Ow + (long)row * D + ch * 8) = v; }
    }
    __syncthreads();
}
#undef KSWZ
#undef SBAR
}

DEV void ph_attn(const Params& P, int bid, int nb, unsigned char* lds_) {
    const int tid = phase_tid(), lane = tid & 63;
    char* lds = (char*)lds_;
    const bf16* proj = (const bf16*)(P.ws + WS_PROJ); bf16* ycat = (bf16*)(P.ws + WS_YCAT);
    const float* lq = P.in[15]; const float* go = P.in[16]; const float* rb = P.in[17];
    const float s01 = wave_sum(lq[lane] * lq[64 + lane]), s23 = wave_sum(lq[128 + lane] * lq[192 + lane]);
    const float lamv = __expf(s01) - __expf(s23) + LAM_INIT;
    __syncthreads();
    { float* tabs = (float*)(lds + att::LDS_TAB);
      for (int i = tid; i < 4 * att::TABN; i += NTHR) { const int hd = i / att::TABN, rel = i % att::TABN - att::TABOFF;
          tabs[i] = (rb[t5_bucket(rel) * NH + hd] - rb[15 * NH + hd]) * att::LOG2E; } }
    __syncthreads();
    const int vcu = (bid % 8) * (nb / 8) + bid / 8, xg = vcu >> 5, c = vcu & 31;
    for (int i = 0; i < 4; ++i) {
        const int bh = xg * 4 + i, b = bh >> 2, hd = bh & 3;
        const float fsw = __expf(rb[15 * NH + hd] - rb[31 * NH + hd]);
        att::attn_unit(proj, (const unsigned char*)(P.ws + WS_QK8), ycat, b, hd, c, lds, fsw, lamv, go);
    }
}

DEV void ph_outproj(const Params& P, int bid, int nb, unsigned char* lds) {
    pg8::StaticOrder S; S.init((const bf16*)(P.ws + WS_YCAT), (const bf16*)(P.ws + WS_WOUT), T, D, D, nb, bid);
    pg8::EpiResGate E{P.in[0], (bf16*)P.out + X1_OFF, X1_LD, (const float*)(P.ws + WS_MOD)};
    pg8::gemm_phase<pg8::EpiResGate, pg8::StaticOrder, true, false>((LAS unsigned char*)lds, D * 2, S, E);
}

DEV void ph_h2(const Params& P, int bid, int nb, unsigned char* lds) {
    const int tid = phase_tid(), lane = tid & 63, wave = tid >> 6;
    const bf16* x1 = (const bf16*)P.out + X1_OFF; const float* g2 = P.in[19]; const float* wr = P.in[20]; const float* mod = (const float*)(P.ws + WS_MOD);
    unsigned char* h2 = (unsigned char*)(P.ws + WS_H2); float* aff = (float*)(P.ws + WS_AFF);
    float* gm = (float*)lds;
    float* sh = gm + D;
    bf16x8* Whi = (bf16x8*)(lds + 8192);
    bf16x8* Wlo = Whi + 32 * 64;
    float* rsd = (float*)(lds + 8192 + 2 * 32 * 64 * 16) + wave * 16;
    for (int blk = bid; blk < T / 128; blk += nb) {
        const int b = (blk * 128) >> 12;
        __syncthreads();
        { const float* scl = mod + b * 6 * D + 4 * D; const float* shf = mod + b * 6 * D + 3 * D;
          for (int k = tid; k < D; k += NTHR) { gm[k] = g2[k] * (1.f + scl[k]); sh[k] = shf[k]; }
          for (int q = tid; q < 32 * 64; q += NTHR) { const int ks = q >> 6, l = q & 63, e = l & 15, kg = l >> 4; unsigned hi4[4], lo4[4];
#pragma unroll
              for (int jj = 0; jj < 4; ++jj) { const float w0 = wr[(size_t)(ks * 32 + kg * 8 + 2 * jj) * NE + e], w1 = wr[(size_t)(ks * 32 + kg * 8 + 2 * jj + 1) * NE + e];
                  const unsigned h0 = f2bf(w0), h1 = f2bf(w1); hi4[jj] = h0 | (h1 << 16);
                  lo4[jj] = pk2(w0 - __uint_as_float(h0 << 16), w1 - __uint_as_float(h1 << 16)); }
              const u32x4 vh = {hi4[0], hi4[1], hi4[2], hi4[3]}, vl = {lo4[0], lo4[1], lo4[2], lo4[3]};
              Whi[q] = *reinterpret_cast<const bf16x8*>(&vh); Wlo[q] = *reinterpret_cast<const bf16x8*>(&vl); } }
        __syncthreads();
        const int r0 = blk * 128 + wave * 16;
        { const int rsub = lane >> 3, ch = lane & 7; float ss0 = 0.f, ss1 = 0.f;
          const bf16* xa = x1 + (size_t)(r0 + rsub) * X1_LD + ch * 8; const bf16* xb = xa + (size_t)8 * X1_LD;
#pragma unroll 4
          for (int c = 0; c < 16; ++c) { const u32x4 va = *(const u32x4*)(xa + c * 64), vb = *(const u32x4*)(xb + c * 64);
              const unsigned wa[4] = {va.x, va.y, va.z, va.w}, wb[4] = {vb.x, vb.y, vb.z, vb.w};
#pragma unroll
              for (int i = 0; i < 4; ++i) { const float a0 = __uint_as_float(wa[i] << 16), a1 = __uint_as_float(wa[i] & 0xffff0000u), b0 = __uint_as_float(wb[i] << 16), b1 = __uint_as_float(wb[i] & 0xffff0000u);
                  ss0 += a0 * a0 + a1 * a1; ss1 += b0 * b0 + b1 * b1; } }
          ss0 += __shfl_xor(ss0, 1); ss0 += __shfl_xor(ss0, 2); ss0 += __shfl_xor(ss0, 4);
          ss1 += __shfl_xor(ss1, 1); ss1 += __shfl_xor(ss1, 2); ss1 += __shfl_xor(ss1, 4);
          if (ch == 0) { rsd[rsub] = rsqrtf(ss0 * (1.f / D) + EPS); rsd[8 + rsub] = rsqrtf(ss1 * (1.f / D) + EPS); }
          LDS_WAIT(); }
        const int row = lane & 15, kg = lane >> 4;
        const float rstd = rsd[row];
        const bf16* xr = x1 + (size_t)(r0 + row) * X1_LD + kg * 8;
        unsigned char* hr = h2 + (size_t)(r0 + row) * D + kg * 8;
        f32x4 acc = {0.f, 0.f, 0.f, 0.f};
#pragma unroll 2
        for (int ks = 0; ks < 32; ++ks) {
            const u32x4 xv = *(const u32x4*)(xr + ks * 32); const unsigned xw[4] = {xv.x, xv.y, xv.z, xv.w};
            const f32x4 g0 = *(const f32x4*)(gm + ks * 32 + kg * 8), g1 = *(const f32x4*)(gm + ks * 32 + kg * 8 + 4), s0 = *(const f32x4*)(sh + ks * 32 + kg * 8), s1 = *(const f32x4*)(sh + ks * 32 + kg * 8 + 4);
            const float gg[8] = {g0.x, g0.y, g0.z, g0.w, g1.x, g1.y, g1.z, g1.w}, ssv[8] = {s0.x, s0.y, s0.z, s0.w, s1.x, s1.y, s1.z, s1.w};
            float o[8]; unsigned hi4[4], lo4[4];
#pragma unroll
            for (int i = 0; i < 4; ++i) { o[2 * i] = __uint_as_float(xw[i] << 16) * rstd * gg[2 * i] + ssv[2 * i]; o[2 * i + 1] = __uint_as_float(xw[i] & 0xffff0000u) * rstd * gg[2 * i + 1] + ssv[2 * i + 1];
                const unsigned h0 = f2bf(o[2 * i]), h1 = f2bf(o[2 * i + 1]); hi4[i] = h0 | (h1 << 16);
                lo4[i] = pk2(o[2 * i] - __uint_as_float(h0 << 16), o[2 * i + 1] - __uint_as_float(h1 << 16)); }
            *(u32x2*)(hr + ks * 32) = (u32x2){pk4_fp8(o[0], o[1], o[2], o[3]), pk4_fp8(o[4], o[5], o[6], o[7])};
            const u32x4 vh = {hi4[0], hi4[1], hi4[2], hi4[3]}, vl = {lo4[0], lo4[1], lo4[2], lo4[3]};
            const bf16x8 ah = *reinterpret_cast<const bf16x8*>(&vh), al = *reinterpret_cast<const bf16x8*>(&vl);
            const bf16x8 bh = Whi[ks * 64 + lane], bl = Wlo[ks * 64 + lane];
            acc = __builtin_amdgcn_mfma_f32_16x16x32_bf16(ah, bh, acc, 0, 0, 0);
            acc = __builtin_amdgcn_mfma_f32_16x16x32_bf16(ah, bl, acc, 0, 0, 0);
            acc = __builtin_amdgcn_mfma_f32_16x16x32_bf16(al, bh, acc, 0, 0, 0);
        }
#pragma unroll
        for (int rg = 0; rg < 4; ++rg) { float v = acc[rg], mx = v;
            mx = fmaxf(mx, __shfl_xor(mx, 1)); mx = fmaxf(mx, __shfl_xor(mx, 2)); mx = fmaxf(mx, __shfl_xor(mx, 4)); mx = fmaxf(mx, __shfl_xor(mx, 8));
            const float pe = __expf(v - mx); float se = pe;
            se += __shfl_xor(se, 1); se += __shfl_xor(se, 2); se += __shfl_xor(se, 4); se += __shfl_xor(se, 8);
            aff[(size_t)(r0 + kg * 4 + rg) * NE + row] = pe / se; }
    }
}

DEV unsigned block_excl_scan(unsigned v, unsigned* sh  , int tid, unsigned& total) {
    const int lane = tid & 63, wave = tid >> 6;
    unsigned x = v;
#pragma unroll
    for (int o = 1; o < 64; o <<= 1) { const unsigned y = __shfl_up(x, o); if (lane >= o) x += y; }
    __syncthreads();
    if (lane == 63) sh[wave] = x;
    __syncthreads();
    unsigned base = 0, tot = 0;
#pragma unroll
    for (int w = 0; w < NWAVE; ++w) { const unsigned s = sh[w]; if (w < wave) base += s; tot += s; }
    total = tot;
    return base + x - v;
}
DEV void topk_be(const Params& P, const int b, const int e, const int pm, unsigned char* lds, LAS int* rowtab, LAS float* gvtab) {
    const int tid = phase_tid();
    const float* aff = (const float*)(P.ws + WS_AFF);
    int* sel = (int*)(P.ws + WS_SEL);
    unsigned* hist = (unsigned*)lds;
    unsigned* sh = hist + 256;
    unsigned* sh2 = sh + 16;
    {
        unsigned key[8];
#pragma unroll
        for (int i = 0; i < 8; ++i) key[i] = __float_as_uint(aff[((size_t)b * S + tid * 8 + i) * NE + e]);
        unsigned prefix = 0, krem = CAP;
#pragma unroll
        for (int pass = 0; pass < 4; ++pass) {
            const int shift = 24 - 8 * pass;
            __syncthreads();
            if (tid < 256) hist[tid] = 0u;
            __syncthreads();
#pragma unroll
            for (int i = 0; i < 8; ++i) { const bool in = (pass == 0) || ((key[i] >> (shift + 8)) == (prefix >> (shift + 8))); if (in) atomicAdd(&hist[(key[i] >> shift) & 255u], 1u); }
            __syncthreads();
            if (tid < 64) {
                const int l = tid; unsigned c4[4]; unsigned s = 0;
#pragma unroll
                for (int q = 0; q < 4; ++q) { c4[q] = hist[255 - 4 * l - q]; s += c4[q]; }
                unsigned inc = s;
#pragma unroll
                for (int o = 1; o < 64; o <<= 1) { const unsigned y = __shfl_up(inc, o); if (l >= o) inc += y; }
                const unsigned exc = inc - s;
                if (exc < krem && inc >= krem) { unsigned cum = exc; int binsel = 0; unsigned kr = krem;
#pragma unroll
                    for (int q = 0; q < 4; ++q) { if (cum < krem && cum + c4[q] >= krem) { binsel = 255 - 4 * l - q; kr = krem - cum; } cum += c4[q]; }
                    sh2[0] = (unsigned)binsel; sh2[1] = kr; }
            }
            __syncthreads();
            prefix |= sh2[0] << shift; krem = sh2[1];
        }
        unsigned ng = 0, neq = 0;
#pragma unroll
        for (int i = 0; i < 8; ++i) { ng += key[i] > prefix ? 1u : 0u; neq += key[i] == prefix ? 1u : 0u; }
        unsigned tot;
        const unsigned eqbase = block_excl_scan(neq, sh, tid, tot);
        unsigned nsel = 0; unsigned selmask = 0; unsigned er = eqbase;
#pragma unroll
        for (int i = 0; i < 8; ++i) { bool s_ = key[i] > prefix; if (key[i] == prefix) { s_ = er < krem; ++er; } if (s_) { selmask |= 1u << i; ++nsel; } }
        unsigned pos = block_excl_scan(nsel, sh, tid, tot);
        int* selp = sel + ((size_t)(b * NE + e)) * S + tid * 8;
        const bool mine = (tid >> 8) == pm;
        int sv[8];
#pragma unroll
        for (int i = 0; i < 8; ++i) {
            if (selmask & (1u << i)) { const unsigned lp = pos - (unsigned)pm * 256u; if (lp < 256u) { rowtab[lp] = tid * 8 + i; gvtab[lp] = __uint_as_float(key[i]); } sv[i] = (int)pos; ++pos; }
            else sv[i] = -1;
        }
        if (mine) { *(i32x4*)selp = (i32x4){sv[0], sv[1], sv[2], sv[3]}; *(i32x4*)(selp + 4) = (i32x4){sv[4], sv[5], sv[6], sv[7]}; }
    }
    __syncthreads();
}

DEV void ph_moe_up(const Params& P, int bid, int nb, unsigned char* lds) {
    const int vcu = (bid % 8) * (nb / 8) + bid / 8;
    pg8::MoeUpOrder S; S.e = vcu >> 4; S.b = (vcu & 15) >> 1; S.pm = vcu & 1; S.g = S.b * NE + S.e;
    S.h2 = (const char*)(P.ws + WS_H2); S.w1 = (const char*)(P.ws + WS_W1); S.w3 = (const char*)(P.ws + WS_W3);
    LAS int* rowtab = (LAS int*)((LAS unsigned char*)lds + LDS_MISC + 1024);
    LAS float* gvtab = (LAS float*)((LAS unsigned char*)lds + LDS_MISC + 2048);
    __syncthreads();
    topk_be(P, S.b, S.e, S.pm, lds, rowtab, gvtab);
    S.rowtab = rowtab;
    pg8::EpiSwiGLU E{(unsigned char*)(P.ws + WS_HB), gvtab};
    pg8::gemm_phase<pg8::EpiSwiGLU, pg8::MoeUpOrder, true, true, true>((LAS unsigned char*)lds, D, S, E);
}

DEV void ph_moe_down(const Params& P, int bid, int nb, unsigned char* lds) {
    const int vcu = (bid % 8) * (nb / 8) + bid / 8;
    pg8::MoeDownOrder S; S.e = vcu >> 4; S.pm = vcu & 1; S.g = ((vcu & 15) >> 1) * NE + S.e;
    S.hb = (const char*)(P.ws + WS_HB); S.w2 = (const char*)(P.ws + WS_W2);
    pg8::EpiScaleRow E{(unsigned char*)(P.ws + WS_YB)};
    pg8::gemm_phase<pg8::EpiScaleRow, pg8::MoeDownOrder, true, false, true>((LAS unsigned char*)lds, D, S, E);
}

DEV void ph_final(const Params& P, int bid, int nb, bool probe = false) {
    const int tid = phase_tid(), lane = tid & 63, wave = tid >> 6;
    const float* mod = (const float*)(P.ws + WS_MOD); const int* sel = (const int*)(P.ws + WS_SEL); const unsigned char* yb = (const unsigned char*)(P.ws + WS_YB);
    float* out = P.out; float* dst = probe ? (float*)(P.ws + WS_PROJ) : P.out;
    const int gw = bid * NWAVE + wave, ngw = nb * NWAVE;
    for (int row0 = gw; row0 < T; row0 += 2 * ngw) {
        const int rowA = row0, rowB = row0 + ngw < T ? row0 + ngw : row0; const bool hasB = row0 + ngw < T;
        const int bA = rowA >> 12, bB = rowB >> 12;
        u32x2 xa[4], xb[4];
#pragma unroll
        for (int j = 0; j < 4; ++j) { xa[j] = ((const u32x2*)((const bf16*)out + (size_t)rowA * X1_LD + X1_OFF) + lane)[64 * j]; xb[j] = ((const u32x2*)((const bf16*)out + (size_t)rowB * X1_LD + X1_OFF) + lane)[64 * j]; }
        const int e16 = lane & 15;
        const int cA = sel[((size_t)(bA * NE + e16)) * S + (rowA & (S - 1))], cB = sel[((size_t)(bB * NE + e16)) * S + (rowB & (S - 1))];
        unsigned mA = (unsigned)(__ballot(cA >= 0) & 0xFFFFull), mB = (unsigned)(__ballot(cB >= 0) & 0xFFFFull);
        float accA[16], accB[16];
#pragma unroll
        for (int i = 0; i < 16; ++i) { accA[i] = 0.f; accB[i] = 0.f; }
#define ACCROW(ACC, M, CV, BB) do { while (M) { const int e0 = __builtin_ctz(M); M &= M - 1; const int c0 = __builtin_amdgcn_readlane(CV, e0); \
            int e1 = -1, c1 = 0; if (M) { e1 = __builtin_ctz(M); M &= M - 1; c1 = __builtin_amdgcn_readlane(CV, e1); } \
            const unsigned char* y0 = yb + ((size_t)((BB) * NE + e0) * CAP + c0) * D; const unsigned char* y1 = yb + ((size_t)((BB) * NE + (e1 < 0 ? e0 : e1)) * CAP + (e1 < 0 ? c0 : c1)) * D; \
            int w0[4], w1[4]; \
            _Pragma("unroll") for (int j = 0; j < 4; ++j) { w0[j] = *(const int*)(y0 + 4 * lane + 256 * j); w1[j] = *(const int*)(y1 + 4 * lane + 256 * j); } \
            const float f1 = e1 < 0 ? 0.f : 1.f; \
            _Pragma("unroll") for (int j = 0; j < 4; ++j) { \
                const f32x2 p0 = __builtin_amdgcn_cvt_pk_f32_fp8(w0[j], false), p1 = __builtin_amdgcn_cvt_pk_f32_fp8(w0[j], true), q0 = __builtin_amdgcn_cvt_pk_f32_fp8(w1[j], false), q1 = __builtin_amdgcn_cvt_pk_f32_fp8(w1[j], true); \
                ACC[4 * j] += p0.x + f1 * q0.x; ACC[4 * j + 1] += p0.y + f1 * q0.y; ACC[4 * j + 2] += p1.x + f1 * q1.x; ACC[4 * j + 3] += p1.y + f1 * q1.y; } } } while (0)
        ACCROW(accA, mA, cA, bA);
        if (hasB) ACCROW(accB, mB, cB, bB);
#undef ACCROW
        const float* gA = mod + bA * 6 * D + 5 * D; const float* gB = mod + bB * 6 * D + 5 * D;
#pragma unroll
        for (int j = 0; j < 4; ++j) { const int k = 4 * lane + 256 * j; const f32x4 g = *(const f32x4*)(gA + k) * 0.03125f;
            f32x4 v = {__uint_as_float(xa[j].x << 16), __uint_as_float(xa[j].x & 0xffff0000u), __uint_as_float(xa[j].y << 16), __uint_as_float(xa[j].y & 0xffff0000u)};
            v.x += g.x * accA[4 * j]; v.y += g.y * accA[4 * j + 1]; v.z += g.z * accA[4 * j + 2]; v.w += g.w * accA[4 * j + 3]; *(f32x4*)(dst + (size_t)rowA * D + k) = v; }
        if (hasB) {
#pragma unroll
            for (int j = 0; j < 4; ++j) { const int k = 4 * lane + 256 * j; const f32x4 g = *(const f32x4*)(gB + k) * 0.03125f;
                f32x4 v = {__uint_as_float(xb[j].x << 16), __uint_as_float(xb[j].x & 0xffff0000u), __uint_as_float(xb[j].y << 16), __uint_as_float(xb[j].y & 0xffff0000u)};
                v.x += g.x * accB[4 * j]; v.y += g.y * accB[4 * j + 1]; v.z += g.z * accB[4 * j + 2]; v.w += g.w * accB[4 * j + 3]; *(f32x4*)(dst + (size_t)rowB * D + k) = v; }
        }
    }
}

constexpr int NPHASE = 11;
template <int PH> DEV void run_phase(const Params& P, int bid, int nb, unsigned char* lds) {
    if constexpr (PH == 0) ph_mod(P, bid, nb, lds);
    if constexpr (PH == 1) { ph_h(P, bid, nb); ph_prep(P, bid, nb, lds); }
    if constexpr (PH == 2) ph_inproj(P, bid, nb, lds);
    if constexpr (PH == 3) ph_lru_pass(P, bid, nb, lds, 0);
    if constexpr (PH == 4) { ph_lru_pass(P, bid, nb, lds, 1); ph_attn(P, bid, nb, lds); }
    if constexpr (PH == 5) ph_outproj(P, bid, nb, lds);
    if constexpr (PH == 6) ph_h2(P, bid, nb, lds);
    if constexpr (PH == 8) ph_moe_up(P, bid, nb, lds);
    if constexpr (PH == 9) ph_moe_down(P, bid, nb, lds);
    if constexpr (PH == 10) ph_final(P, bid, nb);
    if constexpr (PH == 20) ph_lru_pass(P, bid, nb, lds, 0);
    if constexpr (PH == 21) ph_lru_pass(P, bid, nb, lds, 1);
    if constexpr (PH == 22) ph_attn(P, bid, nb, lds);
    if constexpr (PH == 23) ph_qknorm_conv(P, bid, nb, true);
    if constexpr (PH == 24) ph_final(P, bid, nb, true);
}
#if MK_SINGLE
__global__ void __launch_bounds__(NTHR, 2) mega(Params P) {
    extern __shared__ __attribute__((aligned(16))) unsigned char lds[];
    const int bid = blockIdx.x, nb = gridDim.x;
    volatile LAS unsigned* MISC = (volatile LAS unsigned*)((LAS unsigned char*)lds + LDS_MISC);
    tid_table_init();
    for (int u = threadIdx.x; u < 64; u += NTHR) MISC[u] = 0u;
    __syncthreads();
    (void)xcd_barrier_post((unsigned*)(P.ws + WS_CTL) + 4096, MISC + 8);
#define SEAM() do { XcdBarrier bar_; bar_.bar = (unsigned*)(P.ws + WS_CTL) + 4096; bar_.x = xb_xcc_id(); \
        bar_.st = (volatile LAS unsigned*)((LAS unsigned char*)lds + LDS_MISC) + 8; xcd_barrier(bar_); } while (0)
    run_phase<0>(P, bid, nb, lds); SEAM();
    run_phase<1>(P, bid, nb, lds); SEAM();
    run_phase<2>(P, bid, nb, lds); SEAM();
    run_phase<3>(P, bid, nb, lds); SEAM();
    run_phase<4>(P, bid, nb, lds); SEAM();
    run_phase<5>(P, bid, nb, lds); SEAM();
    run_phase<6>(P, bid, nb, lds); SEAM();
    run_phase<8>(P, bid, nb, lds); SEAM();
    run_phase<9>(P, bid, nb, lds); SEAM();
#undef SEAM
    run_phase<10>(P, bid, nb, lds);
}
#else
template <int PH> __global__ void __launch_bounds__(NTHR, 2) phase_kernel(Params P) {
    extern __shared__ __attribute__((aligned(16))) unsigned char lds[];
    tid_table_init(); __syncthreads();
    run_phase<PH>(P, blockIdx.x, gridDim.x, lds);
}
#ifndef PROBE_PH
#define PROBE_PH -1
#endif
#ifndef PROBE_REP
#define PROBE_REP 1
#endif
template <int PH> static void launch_phase(int grid, hipStream_t stream, const Params& p) {
    static bool attr = false;
    if (!attr) { (void)hipFuncSetAttribute((const void*)phase_kernel<PH>, hipFuncAttributeMaxDynamicSharedMemorySize, LDS_BYTES); attr = true; }
    hipLaunchKernelGGL(phase_kernel<PH>, dim3(grid), dim3(NTHR), LDS_BYTES, stream, p);
    if (PROBE_PH == PH) for (int r = 0; r < PROBE_REP; ++r) hipLaunchKernelGGL(phase_kernel<PH>, dim3(grid), dim3(NTHR), LDS_BYTES, stream, p);
    if (PH == 3 && PROBE_PH == 20) for (int r = 0; r < PROBE_REP; ++r) hipLaunchKernelGGL(phase_kernel<20>, dim3(grid), dim3(NTHR), LDS_BYTES, stream, p);
    if (PH == 4 && PROBE_PH == 21) for (int r = 0; r < PROBE_REP; ++r) hipLaunchKernelGGL(phase_kernel<21>, dim3(grid), dim3(NTHR), LDS_BYTES, stream, p);
    if (PH == 4 && PROBE_PH == 22) for (int r = 0; r < PROBE_REP; ++r) hipLaunchKernelGGL(phase_kernel<22>, dim3(grid), dim3(NTHR), LDS_BYTES, stream, p);
    if (PH == 3 && PROBE_PH == 23) for (int r = 0; r < PROBE_REP; ++r) hipLaunchKernelGGL(phase_kernel<23>, dim3(grid), dim3(NTHR), LDS_BYTES, stream, p);
    if (PH == 9 && PROBE_PH == 24) for (int r = 0; r < PROBE_REP; ++r) hipLaunchKernelGGL(phase_kernel<24>, dim3(grid), dim3(NTHR), LDS_BYTES, stream, p);
}
#endif

extern "C" void kernel_launch(void* const* d_in, const int* in_sizes, int n_in, void* d_out, int out_size, void* d_ws, size_t ws_size, hipStream_t stream) {
    static int grid = 0;
    if (grid == 0) {
        if (n_in != 24 || out_size != T * D || ws_size < WS_END) { fprintf(stderr, "kernel_launch: unexpected shapes (n_in %d out %d ws %zu)\n", n_in, out_size, ws_size); grid = -1; return; }
        int dev = 0, cus = 0;
        if (hipGetDevice(&dev) != hipSuccess || hipDeviceGetAttribute(&cus, hipDeviceAttributeMultiprocessorCount, dev) != hipSuccess) { grid = -1; return; }
#if MK_SINGLE
        if (hipFuncSetAttribute((const void*)mega, hipFuncAttributeMaxDynamicSharedMemorySize, LDS_BYTES) != hipSuccess) { fprintf(stderr, "kernel_launch: hipFuncSetAttribute failed\n"); grid = -1; return; }
        int per_cu = 0;
        (void)hipOccupancyMaxActiveBlocksPerMultiprocessor(&per_cu, (const void*)mega, NTHR, LDS_BYTES);
        (void)hipGetLastError();
#endif
        grid = cus;
        if (grid != 256) { fprintf(stderr, "kernel_launch: this build needs a 256-CU device (got %d)\n", cus); grid = -1; return; }
    }
    if (grid < 0) return;
    (void)hipMemsetAsync((char*)d_ws + WS_CTL, 0, 1 * MiB, stream);
    Params p{};
    for (int i = 0; i < 24; ++i) p.in[i] = (const float*)d_in[i];
    p.out = (float*)d_out; p.ws = (unsigned char*)d_ws;
#if MK_SINGLE
    hipLaunchKernelGGL(mega, dim3(grid), dim3(NTHR), LDS_BYTES, stream, p);
#else
    launch_phase<0>(grid, stream, p); launch_phase<1>(grid, stream, p); launch_phase<2>(grid, stream, p); launch_phase<3>(grid, stream, p);
    launch_phase<4>(grid, stream, p); launch_phase<5>(grid, stream, p); launch_phase<6>(grid, stream, p); launch_phase<7>(grid, stream, p);
    launch_phase<8>(grid, stream, p); launch_phase<9>(grid, stream, p); launch_phase<10>(grid, stream, p);
#endif
}
```

```cpp
#include <hip/hip_runtime.h>
#include <cstdint>
#include <cstdio>

#ifndef MK_SINGLE
#define MK_SINGLE 1
#endif

#define DEV __device__ __forceinline__
#define GAS __attribute__((address_space(1)))
#define LAS __attribute__((address_space(3)))
typedef unsigned short bf16;
typedef short bf16x8 __attribute__((ext_vector_type(8)));
typedef float f32x16 __attribute__((ext_vector_type(16)));
typedef float f32x4 __attribute__((ext_vector_type(4)));
typedef unsigned u32x4 __attribute__((ext_vector_type(4)));
typedef int i32x4 __attribute__((ext_vector_type(4)));
typedef float f32x2 __attribute__((ext_vector_type(2)));
typedef unsigned u32x2 __attribute__((ext_vector_type(2)));

constexpr int NB = 8, S = 4096, D = 1024, T = NB * S;
constexpr int DL = 512, NPROJ = 2560, NE = 16, CAP = 512, NH = 4;
constexpr float EPS = 1e-6f;
constexpr float LAM_INIT = 0.2f;
constexpr int NTHR = 512, NWAVE = 8;

constexpr size_t MiB = 1u << 20;
constexpr size_t WS_PROJ = 0;
constexpr size_t WS_HB = 0;
constexpr size_t WS_H = 160 * MiB;
constexpr size_t WS_XCG = 160 * MiB;
constexpr size_t WS_AF = 160 * MiB;
constexpr size_t WS_YB = 160 * MiB;
constexpr size_t WS_YCAT = 224 * MiB;
constexpr size_t WS_XC = 224 * MiB;
constexpr size_t WS_H2 = 288 * MiB;
constexpr size_t WS_UF = 288 * MiB;
constexpr size_t WS_QK8 = 288 * MiB;
constexpr size_t WS_WIN = 352 * MiB;
constexpr size_t WS_WOUT = 357 * MiB;
constexpr size_t WS_W1 = 360 * MiB;
constexpr size_t WS_W3 = 392 * MiB;
constexpr size_t WS_W2 = 424 * MiB;
constexpr size_t WS_CTL = 456 * MiB;
constexpr size_t WS_MOD = 457 * MiB;
constexpr size_t WS_AFF = 458 * MiB;
constexpr size_t WS_IDX = 460 * MiB;
constexpr size_t WS_GVAL = 460 * MiB + 512 * 1024;
constexpr size_t WS_SEL = 461 * MiB;
constexpr size_t WS_BIAS = 463 * MiB;
constexpr size_t WS_LSUM = 463 * MiB + 512 * 1024;
constexpr size_t WS_END = 464 * MiB;

constexpr int X1_LD = 2048, X1_OFF = 1024;
struct Params { const float* in[24]; float* out; unsigned char* ws; };

DEV float bf2f(bf16 v) { return __uint_as_float((unsigned)v << 16); }
DEV unsigned f2bf(float f) { unsigned u = __float_as_uint(f); return (u + 0x7fffu + ((u >> 16) & 1u)) >> 16; }
DEV unsigned pk2(float lo, float hi) { return f2bf(lo) | (f2bf(hi) << 16); }
DEV float wave_sum(float v) {
#pragma unroll
    for (int o = 1; o < 64; o <<= 1) v += __shfl_xor(v, o);
    return v;
}
DEV float sigmoidf_(float x) { return 1.f / (1.f + __expf(-x)); }
DEV float siluf_(float x) { return x / (1.f + __expf(-x)); }
DEV float gelu_tanh(float x) { const float u = 0.7978845608028654f * (x + 0.044715f * x * x * x); return 0.5f * x * (1.f + tanhf(u)); }
DEV float clamp_f8(float v) { return __builtin_amdgcn_fmed3f(v, -448.f, 448.f); }
DEV unsigned pk4_fp8(float a, float b, float c, float d) { int p = 0; p = __builtin_amdgcn_cvt_pk_fp8_f32(clamp_f8(a), clamp_f8(b), p, false); p = __builtin_amdgcn_cvt_pk_fp8_f32(clamp_f8(c), clamp_f8(d), p, true); return (unsigned)p; }
#define LDS_WAIT() asm volatile("s_waitcnt lgkmcnt(0)" ::: "memory")
constexpr int LDS_TIDTAB = 131072 + 12288;
DEV unsigned hw_wave_key() { return (unsigned)__builtin_amdgcn_s_getreg((5 << 11) | 4) & 63u; }
DEV int lane_id() { return (int)__builtin_amdgcn_mbcnt_hi(~0u, __builtin_amdgcn_mbcnt_lo(~0u, 0u)); }
DEV void tid_table_init() { if (lane_id() == 0) ((volatile LAS unsigned*)LDS_TIDTAB)[hw_wave_key()] = threadIdx.x; }
DEV int phase_tid() { int t = (int)((volatile LAS unsigned*)LDS_TIDTAB)[hw_wave_key()] + lane_id(); asm volatile("" : "+v"(t)); return t; }

#define XB_TMO      128
#define XB_XCNT(j)  (256  + 64 * (j))
#define XB_XSUB(j)  (1280 + 64 * (j))
#define XB_XGEN(j)  (2304 + 64 * (j))
#define XB_TOP      3328
#define XB_TOPGEN   3392
#define XCD_BAR_WORDS 3456
#define XB_SPIN_CAP (1u << 22)
DEV unsigned xb_ld(unsigned* p)              { return __hip_atomic_load(p, __ATOMIC_RELAXED, __HIP_MEMORY_SCOPE_AGENT); }
DEV unsigned xb_add(unsigned* p, unsigned v) { return __hip_atomic_fetch_add(p, v, __ATOMIC_RELAXED, __HIP_MEMORY_SCOPE_AGENT); }
DEV unsigned xb_xcc_id() { return (unsigned)__builtin_amdgcn_s_getreg((3 << 11) | 20) & 0xFu; }
#define XB_SPIN(cond, bar) do { unsigned _sp = 0; while (cond) { __builtin_amdgcn_s_sleep(1); \
    if ((++_sp & 255u) == 0u) { if (xb_ld(&(bar)[XB_TMO])) break; if (_sp > XB_SPIN_CAP) { atomicAdd(&(bar)[XB_TMO], 1u); break; } } } } while (0)
struct XcdBarrier { unsigned* bar; unsigned x; volatile LAS unsigned* st; };
DEV XcdBarrier xcd_barrier_post(unsigned* bar, volatile LAS unsigned* st) {
    XcdBarrier b; b.bar = bar; b.x = xb_xcc_id(); b.st = st;
    if (threadIdx.x == 0) (void)xb_add(&bar[XB_XCNT(b.x)], 1u);
    return b;
}
DEV void xcd_barrier_complete(unsigned* bar, unsigned x, unsigned& nloc, unsigned& nx) {
    const unsigned G = gridDim.x * gridDim.y * gridDim.z;
    unsigned sum, cnt, mine, sp = 0u;
    for (;;) {
        sum = 0u; cnt = 0u; mine = 0u;
#pragma unroll
        for (unsigned j = 0; j < 16; ++j) { const unsigned c = xb_ld(&bar[XB_XCNT(j)]); sum += c; cnt += (c > 0u) ? 1u : 0u; mine = (j == x) ? c : mine; }
        if (sum == G) break;
        __builtin_amdgcn_s_sleep(1);
        if ((++sp & 255u) == 0u) { if (xb_ld(&bar[XB_TMO])) break; if (sp > XB_SPIN_CAP) { atomicAdd(&bar[XB_TMO], 1u); break; } }
    }
    nloc = mine > 0u ? mine : 1u; nx = cnt > 0u ? cnt : 1u;
}
DEV void xcd_barrier(const XcdBarrier& b) {
    asm volatile("s_waitcnt vmcnt(0)" ::: "memory");
    __syncthreads();
    if (phase_tid() == 0) {
        unsigned* bar = b.bar;
        __builtin_amdgcn_s_waitcnt(0);
        unsigned nloc = b.st[0], nx = b.st[1];
        if (nloc == 0u) { xcd_barrier_complete(bar, b.x, nloc, nx); b.st[0] = nloc; b.st[1] = nx; }
        const unsigned old = xb_add(&bar[XB_XSUB(b.x)], 1u);
        const unsigned gen = old / nloc;
        if (old + 1u == (gen + 1u) * nloc) {
            __builtin_amdgcn_fence(__ATOMIC_RELEASE, "agent");
            asm volatile("s_waitcnt vmcnt(0)" ::: "memory");
            const unsigned og = xb_add(&bar[XB_TOP], 1u);
            const unsigned tg = og / nx;
            if (og + 1u == (tg + 1u) * nx) xb_add(&bar[XB_TOPGEN], 1u);
            else XB_SPIN(xb_ld(&bar[XB_TOPGEN]) == tg, bar);
            __builtin_amdgcn_fence(__ATOMIC_ACQUIRE, "agent");
            xb_add(&bar[XB_XGEN(b.x)], 1u);
            asm volatile("s_waitcnt vmcnt(0)" ::: "memory");
        } else {
            XB_SPIN(xb_ld(&bar[XB_XGEN(b.x)]) == gen, bar);
            __builtin_amdgcn_fence(__ATOMIC_ACQUIRE, "agent");
            asm volatile("s_waitcnt vmcnt(0)" ::: "memory");
        }
    }
    __syncthreads();
}

constexpr int LDS_SCRATCH = 0;
constexpr int LDS_MISC = 131072;
constexpr int LDS_BYTES = 147456;

DEV void transpose_item(const float* W, int K, int N, bf16* WT, float* scr, int item, int lane) {
    const int nblk = N / 32, kb = item / nblk, nbk = item % nblk, k0 = 64 * kb, n0 = 32 * nbk;
#pragma unroll 8
    for (int i = 0; i < 32; ++i) { const int kk = 2 * i + (lane >> 5); scr[kk * 33 + (lane & 31)] = W[(size_t)(k0 + kk) * N + n0 + (lane & 31)]; }
    LDS_WAIT();
    const int c = lane & 7;
#pragma unroll
    for (int j = 0; j < 4; ++j) { const int n = (lane >> 3) + 8 * j; const float* s = scr + (8 * c) * 33 + n;
        u32x4 o; o.x = pk2(s[0 * 33], s[1 * 33]); o.y = pk2(s[2 * 33], s[3 * 33]); o.z = pk2(s[4 * 33], s[5 * 33]); o.w = pk2(s[6 * 33], s[7 * 33]);
        *(u32x4*)(WT + (size_t)(n0 + n) * K + k0 + 8 * c) = o; }
    LDS_WAIT();
}
DEV void transpose_item_f8(const float* W, int K, int N, unsigned char* WT, float* scr, int item, int lane) {
    const int nblk = N / 32, kb = item / nblk, nbk = item % nblk, k0 = 64 * kb, n0 = 32 * nbk;
#pragma unroll 8
    for (int i = 0; i < 32; ++i) { const int kk = 2 * i + (lane >> 5); scr[kk * 33 + (lane & 31)] = W[(size_t)(k0 + kk) * N + n0 + (lane & 31)]; }
    LDS_WAIT();
    const int c = lane & 7;
#pragma unroll
    for (int j = 0; j < 4; ++j) { const int n = (lane >> 3) + 8 * j; const float* s = scr + (8 * c) * 33 + n;
        int p0 = 0, p1 = 0;
        p0 = __builtin_amdgcn_cvt_pk_fp8_f32(s[0 * 33], s[1 * 33], p0, false); p0 = __builtin_amdgcn_cvt_pk_fp8_f32(s[2 * 33], s[3 * 33], p0, true);
        p1 = __builtin_amdgcn_cvt_pk_fp8_f32(s[4 * 33], s[5 * 33], p1, false); p1 = __builtin_amdgcn_cvt_pk_fp8_f32(s[6 * 33], s[7 * 33], p1, true);
        *(u32x2*)(WT + (size_t)(n0 + n) * K + k0 + 8 * c) = (u32x2){(unsigned)p0, (unsigned)p1}; }
    LDS_WAIT();
}
DEV int t5_bucket(int rel) {
    const int ret = rel > 0 ? 16 : 0; const int n = rel < 0 ? -rel : rel;
    if (n < 8) return ret + n;
    const int l2 = 31 - __clz(n * n);
    int large = 8 + l2 - 6; if (large > 15) large = 15;
    return ret + large;
}
DEV void ph_mod(const Params& P, int bid, int nb, unsigned char* lds) {
    const int tid = phase_tid(), lane = tid & 63, wave = tid >> 6;
    float* sc = (float*)lds;
    float* red = (float*)lds + 8 * 1024;
    const float* c = P.in[1]; const float* wm = P.in[2]; const float* bm = P.in[3];
    float* mod = (float*)(P.ws + WS_MOD);
    __syncthreads();
    for (int i = tid; i < NB * D; i += NTHR) sc[i] = siluf_(c[i]);
    __syncthreads();
    constexpr int CPB = 24;
    for (int it = bid; it < 6 * D / CPB; it += nb) {
        const int j0 = it * CPB, col = lane % CPB, kp = lane / CPB;
        float acc[8];
#pragma unroll
        for (int b = 0; b < 8; ++b) acc[b] = 0.f;
        if (lane < 2 * CPB) {
#pragma unroll 8
            for (int i = 0; i < 64; ++i) { const int k = wave * 128 + 2 * i + kp; const float wv = wm[(size_t)k * (6 * D) + j0 + col];
#pragma unroll
                for (int b = 0; b < 8; ++b) acc[b] += sc[b * D + k] * wv; }
        }
#pragma unroll
        for (int b = 0; b < 8; ++b) { const float o = __shfl(acc[b], (lane + CPB) & 63); if (lane < CPB) red[(wave * 8 + b) * CPB + lane] = acc[b] + o; }
        __syncthreads();
        if (tid < 8 * CPB) { const int b = tid / CPB, cc = tid % CPB; float s = 0.f;
#pragma unroll
            for (int w = 0; w < 8; ++w) s += red[(w * 8 + b) * CPB + cc];
            mod[b * (6 * D) + j0 + cc] = s + bm[j0 + cc]; }
        __syncthreads();
    }
}
DEV void ph_prep(const Params& P, int bid, int nb, unsigned char* lds) {
    const int tid = phase_tid(), lane = tid & 63, wave = tid >> 6;
    float* scr = (float*)lds + wave * (64 * 33);
    const int gw = bid * NWAVE + wave, ngw = nb * NWAVE;
    constexpr int I_IN = (D / 64) * (NPROJ / 32);
    for (int it = gw; it < I_IN; it += ngw) transpose_item(P.in[5], D, NPROJ, (bf16*)(P.ws + WS_WIN), scr, it, lane);
}
constexpr int PREP2_IOUT = (D / 64) * (D / 32), PREP2_IE = (D / 64) * (D / 32), PREP2_NIT = PREP2_IOUT + 3 * NE * PREP2_IE;
struct Prep2Item { const float* src; unsigned char* dst; int k0, n0; bool f8; };
DEV bool prep2_decode(const Params& P, int it, Prep2Item& pi) {
    if (it >= PREP2_NIT) return false;
    int r = it;
    if (r < PREP2_IOUT) { pi.src = P.in[18]; pi.dst = P.ws + WS_WOUT; pi.f8 = false; }
    else { r -= PREP2_IOUT; const int which = r / (NE * PREP2_IE); r -= which * (NE * PREP2_IE); const int e = r / PREP2_IE; r -= e * PREP2_IE;
        pi.src = P.in[which == 0 ? 21 : (which == 1 ? 22 : 23)] + (size_t)e * D * D; pi.dst = P.ws + (which == 0 ? WS_W1 : (which == 1 ? WS_W3 : WS_W2)) + (size_t)e * D * D; pi.f8 = true; }
    pi.k0 = 64 * (r / (D / 32)); pi.n0 = 32 * (r % (D / 32)); return true;
}
DEV void prep2_load(const Prep2Item& pi, int lane, float (&tv)[32]) {
    const float* sp = pi.src + (size_t)(pi.k0 + 32 * (lane >> 5)) * D + pi.n0 + (lane & 31);
#pragma unroll
    for (int i = 0; i < 32; ++i) tv[i] = sp[(size_t)i * D];
}
DEV void prep2_finish(const Prep2Item& pi, int lane, const float (&tv)[32]) {
    const size_t o = (size_t)(pi.n0 + (lane & 31)) * D + pi.k0 + 32 * (lane >> 5);
    if (pi.f8) { unsigned w[8];
#pragma unroll
        for (int i = 0; i < 8; ++i) { int p0 = 0; p0 = __builtin_amdgcn_cvt_pk_fp8_f32(tv[4 * i], tv[4 * i + 1], p0, false); p0 = __builtin_amdgcn_cvt_pk_fp8_f32(tv[4 * i + 2], tv[4 * i + 3], p0, true); w[i] = (unsigned)p0; }
        u32x4* d = (u32x4*)(pi.dst + o); d[0] = (u32x4){w[0], w[1], w[2], w[3]}; d[1] = (u32x4){w[4], w[5], w[6], w[7]}; }
    else { u32x4* d = (u32x4*)((bf16*)pi.dst + o);
#pragma unroll
        for (int i = 0; i < 4; ++i) d[i] = (u32x4){pk2(tv[8 * i], tv[8 * i + 1]), pk2(tv[8 * i + 2], tv[8 * i + 3]), pk2(tv[8 * i + 4], tv[8 * i + 5]), pk2(tv[8 * i + 6], tv[8 * i + 7])}; }
}

DEV void ph_h(const Params& P, int bid, int nb) {
    const int tid = phase_tid(), lane = tid & 63, wave = tid >> 6;
    const float* x = P.in[0]; const float* g1 = P.in[4]; const float* mod = (const float*)(P.ws + WS_MOD);
    bf16* h = (bf16*)(P.ws + WS_H);
    const int gw = bid * NWAVE + wave, ngw = nb * NWAVE;
    for (int row0 = gw; row0 < T; row0 += 2 * ngw) {
        f32x4 v[2][4]; int rows[2];
#pragma unroll
        for (int r = 0; r < 2; ++r) { rows[r] = row0 + r * ngw < T ? row0 + r * ngw : row0; const f32x4* xr = (const f32x4*)(x + (size_t)rows[r] * D) + lane;
#pragma unroll
            for (int j = 0; j < 4; ++j) v[r][j] = xr[64 * j]; }
#pragma unroll
        for (int r = 0; r < 2; ++r) {
            if (r > 0 && row0 + r * ngw >= T) break;
            const int row = rows[r], b = row >> 12; float ss = 0.f;
#pragma unroll
            for (int j = 0; j < 4; ++j) ss += (v[r][j].x * v[r][j].x + v[r][j].y * v[r][j].y) + (v[r][j].z * v[r][j].z + v[r][j].w * v[r][j].w);
            const float rstd = rsqrtf(wave_sum(ss) * (1.f / D) + EPS);
            const float* sh = mod + b * 6 * D; const float* scl = sh + D;
#pragma unroll
            for (int j = 0; j < 4; ++j) {
                const int k = 4 * lane + 256 * j;
                const f32x4 g = *(const f32x4*)(g1 + k), s1 = *(const f32x4*)(scl + k), s0 = *(const f32x4*)(sh + k);
                const float o0 = v[r][j].x * rstd * g.x * (1.f + s1.x) + s0.x, o1 = v[r][j].y * rstd * g.y * (1.f + s1.y) + s0.y;
                const float o2 = v[r][j].z * rstd * g.z * (1.f + s1.z) + s0.z, o3 = v[r][j].w * rstd * g.w * (1.f + s1.w) + s0.w;
                u32x2 o; o.x = pk2(o0, o1); o.y = pk2(o2, o3);
                *(u32x2*)(h + (size_t)row * D + k) = o;
            }
        }
    }
}

template <class ARow, class Epi>
DEV void wave_gemm64(const ARow& arow, const bf16* Bt, int K, int m0, int n0, const Epi& epi, int lane) {
    const int r = lane & 31, hh = lane >> 5;
    const bf16* a0 = arow(m0 + r) + 8 * hh; const bf16* a1 = arow(m0 + 32 + r) + 8 * hh;
    const bf16* b0 = Bt + (size_t)(n0 + r) * K + 8 * hh; const bf16* b1 = Bt + (size_t)(n0 + 32 + r) * K + 8 * hh;
    f32x16 c00 = {}, c01 = {}, c10 = {}, c11 = {};
    for (int k = 0; k < K; k += 16) {
        const bf16x8 fa0 = *(const bf16x8*)(a0 + k), fa1 = *(const bf16x8*)(a1 + k), fb0 = *(const bf16x8*)(b0 + k), fb1 = *(const bf16x8*)(b1 + k);
        c00 = __builtin_amdgcn_mfma_f32_32x32x16_bf16(fa0, fb0, c00, 0, 0, 0);
        c01 = __builtin_amdgcn_mfma_f32_32x32x16_bf16(fa0, fb1, c01, 0, 0, 0);
        c10 = __builtin_amdgcn_mfma_f32_32x32x16_bf16(fa1, fb0, c10, 0, 0, 0);
        c11 = __builtin_amdgcn_mfma_f32_32x32x16_bf16(fa1, fb1, c11, 0, 0, 0);
    }
#pragma unroll
    for (int g = 0; g < 16; ++g) {
        const int rr = (g & 3) + 8 * (g >> 2) + 4 * hh;
        epi(m0 + rr, n0 + r, c00[g]); epi(m0 + rr, n0 + 32 + r, c01[g]);
        epi(m0 + 32 + rr, n0 + r, c10[g]); epi(m0 + 32 + rr, n0 + 32 + r, c11[g]);
    }
}


namespace pg8 {
constexpr int BM = 256, BK = 64, HALF = 128, HTB = HALF * BK * 2, STAGE_BYTES = 8 * HTB, NXCD = 8, WGM = 8;
DEV int lds_byte(int r, int c) { const int st = (r >> 4) * 2 + (c >> 5), rr = r & 15, cc = c & 31, ob = rr * 64 + cc * 2; return st * 1024 + (ob ^ (((ob >> 9) & 1) << 5)); }
DEV void stage_rc(int b, int& R, int& C) { const int st = b / 1024, sb = b % 1024, swz = sb ^ (((sb >> 9) & 1) << 5); R = (st >> 1) * 16 + swz / 64; C = (st & 1) * 32 + (swz % 64) / 2; }
DEV int perm32(int rho) { const int n = rho >> 4, i = rho & 15; return 8 * (i >> 2) + 4 * n + (i & 3); }
struct Unit { int pm, pn, g; };
struct Ptrs { const char* a0; const char* a1; const char* b0; const char* b1; };
DEV unsigned cvt_pk_bf16(float lo, float hi) { unsigned r; asm volatile("v_cvt_pk_bf16_f32 %0, %1, %2" : "=v"(r) : "v"(lo), "v"(hi)); return r; }

struct StaticOrder {
    int nM, nN, nwg, G, c; const char* A; const char* Bt; int K;
    DEV void init(const bf16* A_, const bf16* Bt_, int M, int N, int K_, int G_, int c_) { nM = M / BM; nN = N / BM; nwg = nM * nN; G = G_; c = c_; A = (const char*)A_; Bt = (const char*)Bt_; K = K_; }
    DEV bool next(int i, Unit& u) const {
        const long L = (long)i * G + c; if (L >= nwg) return false;
        int wgid = (int)L; { const int q = nwg / NXCD, r = nwg % NXCD, xcd = wgid % NXCD, off = wgid / NXCD; wgid = (xcd < r ? xcd * (q + 1) : r * (q + 1) + (xcd - r) * q) + off; }
        const int nig = WGM * nN, gid = wgid / nig, fm = gid * WGM, gsz = (nM - fm) < WGM ? (nM - fm) : WGM;
        u.pm = fm + ((wgid % nig) % gsz); u.pn = (wgid % nig) / gsz; u.g = 0; return true;
    }
    DEV void ptrs(const Unit& u, Ptrs& p) const { const size_t hstep = (size_t)HALF * K * 2;
        p.a0 = A + (size_t)u.pm * 2 * hstep; p.a1 = p.a0 + hstep; p.b0 = Bt + (size_t)u.pn * 2 * hstep; p.b1 = p.b0 + hstep; }
    DEV int arow(const Unit&, int, int R) const { return R; }
};

typedef int v8i __attribute__((ext_vector_type(8)));
typedef int v4i __attribute__((ext_vector_type(4)));
template <class Epi, class Sched, bool ALIGN_EPI, bool GATHER, bool F8 = false>
DEV void gemm_phase(LAS unsigned char* lds, const int KB, const Sched& S, const Epi& E) {
    const int tid = phase_tid(), wid = __builtin_amdgcn_readfirstlane(tid >> 6), lane = tid & 63, wr = wid >> 2, wc = wid & 3, fr = lane & 15, fq = lane >> 4;
    const int nt = KB / (BK * 2);
    int sR[2], sC[2]; unsigned voffB[2];
#pragma unroll
    for (int i = 0; i < 2; ++i) { int R, C; stage_rc(tid * 16 + i * 8192, R, C); const int Rb = Epi::PERM ? ((R & ~31) + perm32(R & 31)) : R;
        sR[i] = R; sC[i] = C; voffB[i] = (unsigned)(Rb * KB + C * 2); }
    const size_t kstep = (size_t)(BK * 2);
    const unsigned ldsw = (unsigned)wid * 1024u;
    const int aoff = lds_byte(wr * 64 + fr, fq * 8), boff = lds_byte(wc * 32 + fr, fq * 8);
    const int a8o0 = lds_byte(wr * 64 + fr, (2 * (fq & 1)) * 8) + (fq >> 1) * 1024;
    const int b8o0 = lds_byte(wc * 32 + fr, (2 * (fq & 1)) * 8) + (fq >> 1) * 1024;
#define PG8_SA(b, h) (((b) * 2 + (h)) * HTB)
#define PG8_SB(b, h) ((4 + (b) * 2 + (h)) * HTB)
#define PG8_STAGE(bufoff, gbase, voff) do { const char* gb_ = (const char*)(gbase); asm volatile("" : "+s"(gb_)); _Pragma("unroll") for (int _i = 0; _i < 2; ++_i) { \
        unsigned vo_ = (voff)[_i]; asm volatile("" : "+v"(vo_)); \
        __builtin_amdgcn_global_load_lds((const unsigned*)(gb_ + vo_), (LAS unsigned*)(lds + (bufoff) + ldsw + _i * 8192), 16, 0, 0); } } while (0)
    LAS unsigned char* abase = lds + (F8 ? a8o0 : aoff); LAS unsigned char* bbase = lds + 4 * HTB + (F8 ? b8o0 : boff);
    asm volatile("" : "+v"(abase), "+v"(bbase));
#define PG8_LDA(dst, b, h) do { _Pragma("unroll") for (int m = 0; m < 4; ++m) { _Pragma("unroll") for (int k = 0; k < 2; ++k) dst[m][k] = *(const LAS bf16x8*)(abase + ((b) * 2 + (h)) * HTB + m * 2048 + k * (F8 ? 16 : 1024)); } } while (0)
#define PG8_LDB(dst, b, h) do { _Pragma("unroll") for (int n = 0; n < 2; ++n) { _Pragma("unroll") for (int k = 0; k < 2; ++k) dst[n][k] = *(const LAS bf16x8*)(bbase + ((b) * 2 + (h)) * HTB + n * 2048 + k * (F8 ? 16 : 1024)); } } while (0)
#define PG8_F8V(lo, hi) __builtin_shufflevector(__builtin_bit_cast(v4i, lo), __builtin_bit_cast(v4i, hi), 0, 1, 2, 3, 4, 5, 6, 7)
#define PG8_MMA(ai, bj, At, Bt) do { __builtin_amdgcn_s_setprio(1); _Pragma("unroll") for (int m = 0; m < 4; ++m) _Pragma("unroll") for (int n = 0; n < 2; ++n) { \
        if (F8) { acc[ai][bj][m][n] = __builtin_amdgcn_mfma_scale_f32_16x16x128_f8f6f4(PG8_F8V(Bt[n][0], Bt[n][1]), PG8_F8V(At[m][0], At[m][1]), acc[ai][bj][m][n], 0, 0, 0, 0x7F7F7F7F, 0, 0x7F7F7F7F); } \
        else { _Pragma("unroll") for (int k = 0; k < 2; ++k) acc[ai][bj][m][n] = __builtin_amdgcn_mfma_f32_16x16x32_bf16(Bt[n][k], At[m][k], acc[ai][bj][m][n], 0, 0, 0); } } \
        if (F8) asm volatile("" :: "v"(acc[ai][bj][0][0]), "v"(acc[ai][bj][0][1]), "v"(acc[ai][bj][1][0]), "v"(acc[ai][bj][1][1]), "v"(acc[ai][bj][2][0]), "v"(acc[ai][bj][2][1]), "v"(acc[ai][bj][3][0]), "v"(acc[ai][bj][3][1]));   \
        __builtin_amdgcn_s_setprio(0); } while (0)
#define PG8_WAIT_V(n) asm volatile("s_waitcnt vmcnt(" #n ")" ::: "memory")
#define PG8_WAIT_L(n) asm volatile("s_waitcnt lgkmcnt(" #n ")" ::: "memory")
#define PG8_BAR __builtin_amdgcn_s_barrier()
#define PG8_SCHED __builtin_amdgcn_sched_barrier(0)
    Unit cur, nxt; int ui = 0;
    if (!S.next(0, cur)) return;
    f32x4 acc[2][2][4][2];
#pragma unroll
    for (int a = 0; a < 2; ++a)
#pragma unroll
        for (int b = 0; b < 2; ++b)
#pragma unroll
            for (int m = 0; m < 4; ++m)
#pragma unroll
                for (int n = 0; n < 2; ++n) acc[a][b][m][n] = (f32x4){0.f, 0.f, 0.f, 0.f};
    bf16x8 At[4][2], B0[2][2], B1[2][2];
    Ptrs cp; S.ptrs(cur, cp);
    unsigned vA0[2], vA1[2];
#pragma unroll
    for (int i = 0; i < 2; ++i) { vA0[i] = (unsigned)(S.arow(cur, 0, sR[i]) * KB + sC[i] * 2); vA1[i] = GATHER ? (unsigned)(S.arow(cur, 1, sR[i]) * KB + sC[i] * 2) : vA0[i]; }
    PG8_STAGE(PG8_SB(0, 0), cp.b0, voffB); PG8_STAGE(PG8_SB(0, 1), cp.b1, voffB); PG8_STAGE(PG8_SA(0, 0), cp.a0, vA0); PG8_STAGE(PG8_SA(0, 1), cp.a1, vA1);
    if (wr == 1) PG8_BAR;
    PG8_WAIT_V(2); PG8_BAR;
    PG8_STAGE(PG8_SB(1, 0), cp.b0 + kstep, voffB); PG8_STAGE(PG8_SA(1, 0), cp.a0 + kstep, vA0); PG8_STAGE(PG8_SB(1, 1), cp.b1 + kstep, voffB);
    PG8_WAIT_V(6); PG8_BAR;
    for (;;) {
        const bool has_next = S.next(ui + 1, nxt);
        Ptrs np = cp;
        if (has_next) S.ptrs(nxt, np);
        for (int t = 0; t < nt; t += 2) {
            const bool last = (t == nt - 2);
            const char* a1h1 = cp.a1 + (size_t)(t + 1) * kstep;
            const char* a2h0 = last ? np.a0 : cp.a0 + (size_t)(t + 2) * kstep; const char* a2h1 = last ? np.a1 : cp.a1 + (size_t)(t + 2) * kstep;
            const char* b2h0 = last ? np.b0 : cp.b0 + (size_t)(t + 2) * kstep; const char* b2h1 = last ? np.b1 : cp.b1 + (size_t)(t + 2) * kstep;
            PG8_LDB(B0, 0, 0); PG8_LDB(B1, 0, 1); PG8_SCHED; PG8_LDA(At, 0, 0); PG8_STAGE(PG8_SA(1, 1), a1h1, vA1);
            PG8_WAIT_V(8); PG8_WAIT_L(0); PG8_BAR; PG8_MMA(0, 0, At, B0); PG8_MMA(0, 1, At, B1); PG8_BAR; PG8_SCHED;
            PG8_LDA(At, 0, 1); PG8_STAGE(PG8_SB(0, 0), b2h0, voffB); PG8_STAGE(PG8_SB(0, 1), b2h1, voffB); PG8_STAGE(PG8_SA(0, 0), a2h0, vA0);
            PG8_WAIT_V(8); PG8_WAIT_L(0); PG8_BAR; PG8_MMA(1, 0, At, B0); PG8_MMA(1, 1, At, B1); PG8_BAR; PG8_SCHED;
            PG8_LDB(B0, 1, 0); PG8_LDB(B1, 1, 1); PG8_SCHED; PG8_LDA(At, 1, 0); PG8_STAGE(PG8_SA(0, 1), a2h1, vA1);
            PG8_WAIT_V(8); PG8_WAIT_L(0); PG8_BAR; PG8_MMA(0, 0, At, B0); PG8_MMA(0, 1, At, B1); PG8_BAR; PG8_SCHED;
            PG8_LDA(At, 1, 1); PG8_STAGE(PG8_SB(1, 0), b2h0 + kstep, voffB); PG8_STAGE(PG8_SB(1, 1), b2h1 + kstep, voffB); PG8_STAGE(PG8_SA(1, 0), a2h0 + kstep, vA0);
            PG8_WAIT_V(8); PG8_WAIT_L(0); PG8_BAR; PG8_MMA(1, 0, At, B0); PG8_MMA(1, 1, At, B1); PG8_BAR; PG8_SCHED;
        }
        if constexpr (ALIGN_EPI) { if (wr == 0) PG8_BAR; }
        E(acc, cur, wr, wc, fr, fq);
        if (!has_next) break;
#pragma unroll
        for (int a = 0; a < 2; ++a)
#pragma unroll
            for (int b = 0; b < 2; ++b)
#pragma unroll
                for (int m = 0; m < 4; ++m)
#pragma unroll
                    for (int n = 0; n < 2; ++n) acc[a][b][m][n] = (f32x4){0.f, 0.f, 0.f, 0.f};
        cur = nxt; cp = np; ++ui;
        if constexpr (ALIGN_EPI) { if (wr == 1) PG8_BAR; }
    }
    PG8_WAIT_V(0);
    if constexpr (!ALIGN_EPI) { if (wr == 0) PG8_BAR; }
    PG8_BAR;
#undef PG8_SA
#undef PG8_SB
#undef PG8_STAGE
#undef PG8_LDA
#undef PG8_LDB
#undef PG8_MMA
#undef PG8_F8V
#undef PG8_WAIT_V
#undef PG8_WAIT_L
#undef PG8_BAR
#undef PG8_SCHED
}

struct EpiBf16 {
    static constexpr bool PERM = true;
    bf16* O; int ldc;
    DEV void operator()(const f32x4 (&acc)[2][2][4][2], const Unit& u, int wr, int wc, int fr, int fq) const {
        const int row0 = u.pm * BM + wr * 64 + fr, col0 = u.pn * BM + wc * 32 + 8 * fq;
#pragma unroll
        for (int ai = 0; ai < 2; ++ai)
#pragma unroll
            for (int m = 0; m < 4; ++m) { bf16* rowp = O + (size_t)(row0 + ai * HALF + m * 16) * ldc + col0;
#pragma unroll
                for (int bj = 0; bj < 2; ++bj) { const f32x4 v0 = acc[ai][bj][m][0], v1 = acc[ai][bj][m][1];
                    u32x4 w; w.x = cvt_pk_bf16(v0[0], v0[1]); w.y = cvt_pk_bf16(v0[2], v0[3]); w.z = cvt_pk_bf16(v1[0], v1[1]); w.w = cvt_pk_bf16(v1[2], v1[3]);
                    *(u32x4*)(rowp + bj * HALF) = w; } }
    }
};
struct EpiInProj {
    static constexpr bool PERM = true;
    bf16* O; const float* gq; const float* gk; LAS float* xch; unsigned char* QK8;
    DEV void operator()(const f32x4 (&acc)[2][2][4][2], const Unit& u, int wr, int wc, int fr, int fq) const {
        const int row0 = u.pm * BM + wr * 64 + fr, col0 = u.pn * BM + wc * 32 + 8 * fq;
        const bool isqk = (u.pn >= 4) && (u.pn < 8);
        float rs[2][4][2];
        float gs[8];
        if (isqk) {
            const bool isq = u.pn < 6; const float* g = (isq ? gq : gk) + (wc & 1) * 32 + 8 * fq; const float sc = isq ? 0.125f * 1.4426950408889634f : 1.f;
#pragma unroll
            for (int i = 0; i < 8; ++i) gs[i] = g[i] * sc;
            const int wid = wr * 4 + wc;
#pragma unroll
            for (int ai = 0; ai < 2; ++ai)
#pragma unroll
                for (int m = 0; m < 4; ++m)
#pragma unroll
                    for (int bj = 0; bj < 2; ++bj) { const f32x4 v0 = acc[ai][bj][m][0], v1 = acc[ai][bj][m][1];
                        float s = (v0[0] * v0[0] + v0[1] * v0[1]) + (v0[2] * v0[2] + v0[3] * v0[3]) + (v1[0] * v1[0] + v1[1] * v1[1]) + (v1[2] * v1[2] + v1[3] * v1[3]);
                        s += __shfl_xor(s, 16); s += __shfl_xor(s, 32);
                        rs[ai][m][bj] = s;
                        if (fq == 0) xch[(wid * 16 + (ai * 4 + m) * 2 + bj) * 16 + fr] = s; }
            asm volatile("s_waitcnt lgkmcnt(0)" ::: "memory"); __builtin_amdgcn_s_barrier(); asm volatile("" ::: "memory");
            const int pw = wr * 4 + (wc ^ 1);
#pragma unroll
            for (int ai = 0; ai < 2; ++ai)
#pragma unroll
                for (int m = 0; m < 4; ++m)
#pragma unroll
                    for (int bj = 0; bj < 2; ++bj) { const float tot = rs[ai][m][bj] + xch[(pw * 16 + (ai * 4 + m) * 2 + bj) * 16 + fr];
                        rs[ai][m][bj] = rsqrtf(tot * (1.f / 64.f) + EPS); }
        }
#pragma unroll
        for (int ai = 0; ai < 2; ++ai)
#pragma unroll
            for (int m = 0; m < 4; ++m) { bf16* rowp = O + (size_t)(row0 + ai * HALF + m * 16) * NPROJ + col0;
#pragma unroll
                for (int bj = 0; bj < 2; ++bj) { f32x4 v0 = acc[ai][bj][m][0], v1 = acc[ai][bj][m][1];
                    if (isqk) { const float r = rs[ai][m][bj];
                        v0[0] *= r * gs[0]; v0[1] *= r * gs[1]; v0[2] *= r * gs[2]; v0[3] *= r * gs[3]; v1[0] *= r * gs[4]; v1[1] *= r * gs[5]; v1[2] *= r * gs[6]; v1[3] *= r * gs[7];
                        u32x2 w8; w8.x = pk4_fp8(v0[0], v0[1], v0[2], v0[3]); w8.y = pk4_fp8(v1[0], v1[1], v1[2], v1[3]);
                        *(u32x2*)(QK8 + (size_t)(row0 + ai * HALF + m * 16) * 1024 + (u.pn - 4) * BM + bj * HALF + wc * 32 + 8 * fq) = w8; }
                    else { u32x4 w; w.x = cvt_pk_bf16(v0[0], v0[1]); w.y = cvt_pk_bf16(v0[2], v0[3]); w.z = cvt_pk_bf16(v1[0], v1[1]); w.w = cvt_pk_bf16(v1[2], v1[3]);
                        *(u32x4*)(rowp + bj * HALF) = w; } } }
    }
};
struct EpiResGate {
    static constexpr bool PERM = true;
    const float* x; bf16* x1; int ld; const float* mod;
    DEV void operator()(const f32x4 (&acc)[2][2][4][2], const Unit& u, int wr, int wc, int fr, int fq) const {
        const int row0 = u.pm * BM + wr * 64 + fr, col0 = u.pn * BM + wc * 32 + 8 * fq;
        const int b = (u.pm * BM) >> 12;
        f32x4 gv[2][2];
#pragma unroll
        for (int bj = 0; bj < 2; ++bj)
#pragma unroll
            for (int n = 0; n < 2; ++n) gv[bj][n] = *(const f32x4*)(mod + b * 6 * D + 2 * D + col0 + bj * HALF + n * 4);
#pragma unroll
        for (int ai = 0; ai < 2; ++ai)
#pragma unroll
            for (int m = 0; m < 4; ++m) { const int row = row0 + ai * HALF + m * 16;
#pragma unroll
                for (int bj = 0; bj < 2; ++bj) { const float* xp = x + (size_t)row * D + col0 + bj * HALF;
                    const f32x4 v0 = *(const f32x4*)xp + gv[bj][0] * acc[ai][bj][m][0], v1 = *(const f32x4*)(xp + 4) + gv[bj][1] * acc[ai][bj][m][1];
                    u32x4 w; w.x = cvt_pk_bf16(v0[0], v0[1]); w.y = cvt_pk_bf16(v0[2], v0[3]); w.z = cvt_pk_bf16(v1[0], v1[1]); w.w = cvt_pk_bf16(v1[2], v1[3]);
                    *(u32x4*)(x1 + (size_t)row * ld + col0 + bj * HALF) = w; }
                if (m == 3) asm volatile("" ::: "memory"); }
    }
};
}


namespace pg8 {
struct MoeUpOrder {
    int e, b, pm, g; const char* h2; const char* w1; const char* w3; const LAS int* rowtab;
    DEV bool next(int i, Unit& u) const { if (i >= 8) return false; u.pm = pm; u.pn = i; u.g = g; return true; }
    DEV void ptrs(const Unit& u, Ptrs& p) const { p.a0 = h2 + (size_t)b * S * D; p.a1 = p.a0;
        const size_t off = ((size_t)e * D + (size_t)u.pn * HALF) * D; p.b0 = w1 + off; p.b1 = w3 + off; }
    DEV int arow(const Unit&, int half, int R) const { return rowtab[half * HALF + R]; }
};
struct EpiSwiGLU {
    static constexpr bool PERM = true;
    unsigned char* H; const LAS float* gval;
    DEV void operator()(const f32x4 (&acc)[2][2][4][2], const Unit& u, int wr, int wc, int fr, int fq) const {
        { const int t2_ = phase_tid(); fr = t2_ & 15; fq = (t2_ & 63) >> 4; }
        const int row0 = u.g * CAP + u.pm * BM + wr * 64 + fr, col0 = u.pn * HALF + wc * 32 + 8 * fq;
#pragma unroll
        for (int ai = 0; ai < 2; ++ai)
#pragma unroll
            for (int m = 0; m < 4; ++m) { const int row = row0 + ai * HALF + m * 16; unsigned char* rowp = H + (size_t)row * D + col0; const float gs = gval[wr * 64 + fr + ai * HALF + m * 16] * 4.f;
                float o[8];
#pragma unroll
                for (int n = 0; n < 2; ++n)
#pragma unroll
                    for (int j = 0; j < 4; ++j) { const float a = acc[ai][0][m][n][j], bb = acc[ai][1][m][n][j]; o[n * 4 + j] = (a * gs) * __builtin_amdgcn_rcpf(1.f + __builtin_amdgcn_exp2f(a * -1.4426950408889634f)) * bb; }
                u32x2 w; w.x = pk4_fp8(o[0], o[1], o[2], o[3]); w.y = pk4_fp8(o[4], o[5], o[6], o[7]);
                *(u32x2*)rowp = w; }
    }
};
struct MoeDownOrder {
    int e, pm, g; const char* hb; const char* w2;
    DEV bool next(int i, Unit& u) const { if (i >= 4) return false; u.pm = pm; u.pn = i; u.g = g; return true; }
    DEV void ptrs(const Unit& u, Ptrs& p) const { const size_t hstep = (size_t)HALF * D;
        p.a0 = hb + ((size_t)g * CAP + (size_t)pm * BM) * D; p.a1 = p.a0 + hstep; p.b0 = w2 + ((size_t)e * D + (size_t)u.pn * BM) * D; p.b1 = p.b0 + hstep; }
    DEV int arow(const Unit&, int, int R) const { return R; }
};
struct EpiScaleRow {
    static constexpr bool PERM = true;
    unsigned char* Y;
    DEV void operator()(const f32x4 (&acc)[2][2][4][2], const Unit& u, int wr, int wc, int fr, int fq) const {
        { const int t2_ = phase_tid(); fr = t2_ & 15; fq = (t2_ & 63) >> 4; }
        const int row0 = u.g * CAP + u.pm * BM + wr * 64 + fr, col0 = u.pn * BM + wc * 32 + 8 * fq;
#pragma unroll
        for (int ai = 0; ai < 2; ++ai)
#pragma unroll
            for (int m = 0; m < 4; ++m) { unsigned char* rowp = Y + (size_t)(row0 + ai * HALF + m * 16) * D + col0;
#pragma unroll
                for (int bj = 0; bj < 2; ++bj) { const f32x4 v0 = acc[ai][bj][m][0] * 8.f, v1 = acc[ai][bj][m][1] * 8.f;
                    u32x2 w; w.x = pk4_fp8(v0[0], v0[1], v0[2], v0[3]); w.y = pk4_fp8(v1[0], v1[1], v1[2], v1[3]);
                    *(u32x2*)(rowp + bj * HALF) = w; } }
    }
};
}

DEV void ph_inproj(const Params& P, int bid, int nb, unsigned char* lds) {
    pg8::StaticOrder S; S.init((const bf16*)(P.ws + WS_H), (const bf16*)(P.ws + WS_WIN), T, NPROJ, D, nb, bid);
    pg8::EpiInProj E{(bf16*)(P.ws + WS_PROJ), P.in[13], P.in[14], (LAS float*)((LAS unsigned char*)lds + LDS_MISC + 2048), P.ws + WS_QK8};
    pg8::gemm_phase<pg8::EpiInProj, pg8::StaticOrder, true, false>((LAS unsigned char*)lds, D * 2, S, E);
}

DEV void ph_qknorm_conv(const Params& P, int bid, int nb, bool probe = false) {
    const int tid = phase_tid(), lane = tid & 63, wave = tid >> 6;
    bf16* proj = (bf16*)(P.ws + WS_PROJ);
    const float* gq = P.in[13]; const float* gk = P.in[14];
    const int grp = lane >> 2, part = lane & 3;
    const bool isq = grp < 8; const float sc = isq ? 0.125f * 1.4426950408889634f : 1.f;
    float gsc[16];
#pragma unroll
    for (int i = 0; i < 16; ++i) gsc[i] = (isq ? gq : gk)[part * 16 + i] * sc;
    const int gw = bid * NWAVE + wave, ngw = nb * NWAVE;
    for (int row0 = gw; row0 < T; row0 += 4 * ngw) {
        u32x4 w[4][2]; bf16* p[4];
#pragma unroll
        for (int r = 0; r < 4; ++r) { const int row = row0 + r * ngw < T ? row0 + r * ngw : row0; p[r] = proj + (size_t)row * NPROJ + 1024 + grp * 64 + part * 16;
            w[r][0] = *(const u32x4*)p[r]; w[r][1] = *(const u32x4*)(p[r] + 8); }
#pragma unroll
        for (int r = 0; r < 4; ++r) {
            if (r > 0 && row0 + r * ngw >= T) break;
            const unsigned ww[8] = {w[r][0].x, w[r][0].y, w[r][0].z, w[r][0].w, w[r][1].x, w[r][1].y, w[r][1].z, w[r][1].w};
            float v[16]; float ss = 0.f;
#pragma unroll
            for (int i = 0; i < 8; ++i) { v[2 * i] = __uint_as_float(ww[i] << 16); v[2 * i + 1] = __uint_as_float(ww[i] & 0xffff0000u); }
#pragma unroll
            for (int i = 0; i < 16; ++i) ss += v[i] * v[i];
            ss += __shfl_xor(ss, 1); ss += __shfl_xor(ss, 2);
            const float rstd = rsqrtf(ss * (1.f / 64.f) + EPS);
            unsigned o[8];
#pragma unroll
            for (int i = 0; i < 8; ++i) o[i] = pk2(v[2 * i] * rstd * gsc[2 * i], v[2 * i + 1] * rstd * gsc[2 * i + 1]);
            bf16* po = probe ? (bf16*)(P.ws + WS_H) + (p[r] - proj) % (32u << 20) : p[r];
            *(u32x4*)po = (u32x4){o[0], o[1], o[2], o[3]}; *(u32x4*)(po + 8) = (u32x4){o[4], o[5], o[6], o[7]};
        }
    }
}

namespace lru {
typedef float f32x4v __attribute__((ext_vector_type(4)));
constexpr int SUB = 64, SPAN = 1024, NSUB = SPAN / SUB, NSPAN = S / SPAN;
constexpr int G_XL = 0;
constexpr int G_XC = 8704;
constexpr int G_XCB = G_XC + 16384;
constexpr int G_SEG = G_XCB + 64 * 72 * 2;
constexpr int G_CIN = G_SEG + 8192;
constexpr int G_CAR = G_CIN + 4096;
constexpr int G_CW = G_CAR + 512;
constexpr int G_BYTES = G_CW + 1280;
static_assert(2 * G_BYTES <= 131072, "LRU LDS");
DEV float gelu_tanh_fast(float x) { const float u = 0.7978845608028654f * (x + 0.044715f * x * x * x); const float e = __expf(2.f * u); return x * (1.f - __builtin_amdgcn_rcpf(e + 1.f)); }

template <int MODE>
DEV void sweep2(const Params& P, unsigned char* lds0, int b, int n, int span, int bid, int nb) {
    const int tid = phase_tid(), lane = tid & 63, wid = __builtin_amdgcn_readfirstlane(tid >> 6);
    const int dir = wid >> 2, lw = wid & 3, lt = tid & 255;
    unsigned char* lds = lds0 + dir * G_BYTES;
    const bf16* proj = (const bf16*)(P.ws + WS_PROJ); bf16* ycat = (bf16*)(P.ws + WS_YCAT);
    float* sum = (float*)(P.ws + WS_LSUM);
    bf16* XL = (bf16*)(lds + G_XL); float* XC = (float*)(lds + G_XC); bf16* XCB = (bf16*)(lds + G_XCB);
    float* SEG = (float*)(lds + G_SEG); float* CIN = (float*)(lds + G_CIN); float* CAR = (float*)(lds + G_CAR); float* CW = (float*)(lds + G_CW);
    const int ch0 = n * 64;
    const int db = lw, fr = lane & 15, fq = lane >> 4;
    bf16x8 Ba[2], Bx[2];
    { const float* wa = P.in[8] + ((size_t)(dir * 8 + n) * 64) * 64 + db * 16 + fr; const float* wx = P.in[10] + ((size_t)(dir * 8 + n) * 64) * 64 + db * 16 + fr;
#pragma unroll
      for (int ks = 0; ks < 2; ++ks) { unsigned pa[4], px[4];
#pragma unroll
          for (int jj = 0; jj < 4; ++jj) { const int c = ks * 32 + fq * 8 + 2 * jj; pa[jj] = pk2(wa[c * 64], wa[(c + 1) * 64]); px[jj] = pk2(wx[c * 64], wx[(c + 1) * 64]); }
          const u32x4 va = {pa[0], pa[1], pa[2], pa[3]}, vx = {px[0], px[1], px[2], px[3]};
          Ba[ks] = *reinterpret_cast<const bf16x8*>(&va); Bx[ks] = *reinterpret_cast<const bf16x8*>(&vx); } }
    const int cl = db * 16 + fr;
    const int gch = dir * DL + ch0 + cl;
    const float ba = P.in[9][gch], bx = P.in[11][gch];
    float ls; { const float l = P.in[12][gch]; ls = 8.0f * (fminf(l, 0.f) - log1pf(__expf(-fabsf(l)))); }
    const float ls2 = ls * 1.4426950408889634f, nba = -ba * 1.4426950408889634f, nbx = -bx * 1.4426950408889634f;
    __syncthreads();
    CW[lt] = P.in[6][(lt >> 6) * DL + ch0 + (lt & 63)];
    if (lt < 64) {
        CW[256 + lt] = P.in[7][ch0 + lt];
        if (MODE == 1) { float h = 0.f; const float* sp = sum + ((size_t)(b * 2 + dir) * NSPAN) * DL * 2 + (size_t)(ch0 + lt) * 2;
            float2 m4[NSPAN];
#pragma unroll
            for (int s2 = 0; s2 < NSPAN; ++s2) m4[s2] = *(const float2*)(sp + (size_t)s2 * DL * 2);
            if (dir == 0) {
#pragma unroll
                for (int s2 = 0; s2 < NSPAN; ++s2) h = s2 < span ? m4[s2].x * h + m4[s2].y : h;
            } else {
#pragma unroll
                for (int s2 = NSPAN - 1; s2 >= 0; --s2) h = s2 > span ? m4[s2].x * h + m4[s2].y : h;
            }
            CAR[2 * lt + 1] = h; }
    }
    u32x4 xp[3];
    bf16* xcg = (bf16*)(P.ws + WS_XCG);
#define XL_LOAD(kx) do { const int t0_ = span * SPAN + (kx) * SUB; \
        if (MODE == 0) { _Pragma("unroll") for (int q_ = 0; q_ < 3; ++q_) { const int p_ = q_ * 256 + lt; xp[q_] = (u32x4){0u, 0u, 0u, 0u}; \
            if (p_ < 67 * 8) { const int t = t0_ - 2 + (p_ >> 3); if (t >= 0 && t < S) xp[q_] = *(const u32x4*)(proj + ((size_t)b * S + t) * NPROJ + ch0 + (p_ & 7) * 8); } } } \
        else { _Pragma("unroll") for (int q_ = 0; q_ < 2; ++q_) { const int p_ = q_ * 256 + lt; xp[q_] = *(const u32x4*)(xcg + ((size_t)b * S + t0_ + (p_ >> 3)) * DL + ch0 + (p_ & 7) * 8); } } } while (0)
    XL_LOAD(dir == 0 ? 0 : NSUB - 1);
    const int pgw = bid * NWAVE + wid, pngw = nb * NWAVE;
    float Ar = 1.f, Hr = 0.f, hrun = 0.f;
    for (int kk = 0; kk < NSUB; ++kk) {
        const int k = dir == 0 ? kk : NSUB - 1 - kk;
        const int t0 = span * SPAN + k * SUB;
        const size_t row0 = (size_t)b * S + t0;
        Prep2Item pit; float ptv[32]; bool phas = false;
        if (MODE == 0) { phas = prep2_decode(P, pgw + kk * pngw, pit); if (phas) prep2_load(pit, lane, ptv); }
        if (MODE == 0) {
#pragma unroll
            for (int q = 0; q < 3; ++q) { const int p = q * 256 + lt; if (p < 67 * 8) *(u32x4*)(XL + (p >> 3) * 64 + (p & 7) * 8) = xp[q]; }
        } else {
#pragma unroll
            for (int q = 0; q < 2; ++q) { const int p = q * 256 + lt; *(u32x4*)(XCB + (p >> 3) * 72 + (p & 7) * 8) = xp[q]; }
        }
        if (kk + 1 < NSUB) XL_LOAD(dir == 0 ? kk + 1 : NSUB - 2 - kk);
        __syncthreads();
        const bool second = (MODE == 1) && (kk >= NSUB / 2);
        u32x4 pk_h[2], pk_z[2];
        if (second) { const int t = lt >> 2, c16 = (lt & 3) * 16;
            pk_h[0] = *(const u32x4*)(ycat + (row0 + t) * D + ch0 + c16); pk_h[1] = *(const u32x4*)(ycat + (row0 + t) * D + ch0 + c16 + 8);
            pk_z[0] = *(const u32x4*)(proj + (row0 + t) * NPROJ + 512 + ch0 + c16); pk_z[1] = *(const u32x4*)(proj + (row0 + t) * NPROJ + 512 + ch0 + c16 + 8); }
        if (MODE == 0) {
        { const int t = lt >> 2, c16 = (lt & 3) * 16; float acc[16];
#pragma unroll
          for (int i = 0; i < 16; i += 4) { const f32x4v cb4 = *(const f32x4v*)(CW + 256 + c16 + i); acc[i] = cb4.x; acc[i + 1] = cb4.y; acc[i + 2] = cb4.z; acc[i + 3] = cb4.w; }
#pragma unroll
          for (int w = 0; w < 4; ++w) {
#pragma unroll
              for (int hlf = 0; hlf < 2; ++hlf) { const u32x4 xv = *(const u32x4*)(XL + (t + w) * 64 + c16 + hlf * 8); const unsigned xw[4] = {xv.x, xv.y, xv.z, xv.w};
                  const f32x4v w0 = *(const f32x4v*)(CW + w * 64 + c16 + hlf * 8), w1 = *(const f32x4v*)(CW + w * 64 + c16 + hlf * 8 + 4);
                  const float wv[8] = {w0.x, w0.y, w0.z, w0.w, w1.x, w1.y, w1.z, w1.w};
#pragma unroll
                  for (int i = 0; i < 4; ++i) { acc[hlf * 8 + 2 * i] += wv[2 * i] * __uint_as_float(xw[i] << 16); acc[hlf * 8 + 2 * i + 1] += wv[2 * i + 1] * __uint_as_float(xw[i] & 0xffff0000u); } } }
          const u32x4 o0 = {pk2(acc[0], acc[1]), pk2(acc[2], acc[3]), pk2(acc[4], acc[5]), pk2(acc[6], acc[7])}, o1 = {pk2(acc[8], acc[9]), pk2(acc[10], acc[11]), pk2(acc[12], acc[13]), pk2(acc[14], acc[15])};
          *(u32x4*)(XCB + t * 72 + c16) = o0; *(u32x4*)(XCB + t * 72 + c16 + 8) = o1;
          if (dir == (k < NSUB / 2 ? 0 : 1)) { bf16* gp = xcg + (row0 + t) * DL + ch0 + c16; *(u32x4*)gp = o0; *(u32x4*)(gp + 8) = o1; } }
        __syncthreads();
        }
        if (MODE == 1 && kk == 0) hrun = CAR[2 * cl + 1];
        float av[16], uv[16], EA[4], EH[4], TA[4], TH[4];
        const bool first = (dir == 0) ? !(fq & 1) : (fq & 1), firstpair = (dir == 0) ? !(fq & 2) : ((fq & 2) != 0);
#pragma unroll
        for (int tb = 0; tb < 4; ++tb) {
            f32x4v ga = {0.f, 0.f, 0.f, 0.f}, gx = {0.f, 0.f, 0.f, 0.f};
#pragma unroll
            for (int ks = 0; ks < 2; ++ks) { const bf16x8 af = *(const bf16x8*)(XCB + (tb * 16 + fr) * 72 + ks * 32 + fq * 8);
                ga = __builtin_amdgcn_mfma_f32_16x16x32_bf16(af, Ba[ks], ga, 0, 0, 0); gx = __builtin_amdgcn_mfma_f32_16x16x32_bf16(af, Bx[ks], gx, 0, 0, 0); }
#pragma unroll
            for (int rg = 0; rg < 4; ++rg) { const int t = tb * 16 + fq * 4 + rg;
                const float r = __builtin_amdgcn_rcpf(1.f + __builtin_amdgcn_exp2f(__builtin_fmaf(ga[rg], -1.4426950408889634f, nba)));
                const float ig = __builtin_amdgcn_rcpf(1.f + __builtin_amdgcn_exp2f(__builtin_fmaf(gx[rg], -1.4426950408889634f, nbx)));
                const float a = __builtin_amdgcn_exp2f(r * ls2); av[tb * 4 + rg] = a;
                uv[tb * 4 + rg] = __builtin_amdgcn_sqrtf(fmaxf(__builtin_fmaf(-a, a, 1.f), 0.f)) * (ig * bf2f(XCB[t * 72 + cl])); }
            float A = 1.f, H = 0.f;
            if (dir == 0) {
#pragma unroll
                for (int i = 0; i < 4; ++i) { H = av[tb * 4 + i] * H + uv[tb * 4 + i]; A *= av[tb * 4 + i]; }
            } else {
#pragma unroll
                for (int i = 3; i >= 0; --i) { H = av[tb * 4 + i] * H + uv[tb * 4 + i]; A *= av[tb * 4 + i]; }
            }
            const float oA = __shfl_xor(A, 16), oH = __shfl_xor(H, 16);
            const float PA = A * oA, PH = first ? (oA * H + oH) : (A * oH + H);
            const float QA = __shfl_xor(PA, 32), QH = __shfl_xor(PH, 32);
            TA[tb] = PA * QA; TH[tb] = firstpair ? (QA * PH + QH) : (PA * QH + PH);
            const float XA = first ? 1.f : oA, XH = first ? 0.f : oH, YA = firstpair ? 1.f : QA, YH = firstpair ? 0.f : QH;
            EA[tb] = XA * YA; EH[tb] = XA * YH + XH;
        }
        if (MODE == 0) {
            if (dir == 0) {
#pragma unroll
                for (int tb = 0; tb < 4; ++tb) { Hr = TA[tb] * Hr + TH[tb]; Ar *= TA[tb]; }
            } else {
#pragma unroll
                for (int tb = 3; tb >= 0; --tb) { Hr = TA[tb] * Hr + TH[tb]; Ar *= TA[tb]; }
            }
        }
        if (MODE == 0) { if (phas) prep2_finish(pit, lane, ptv); }
        if (MODE == 1) {
            if (dir == 0) {
#pragma unroll
                for (int tb = 0; tb < 4; ++tb) { float h = EA[tb] * hrun + EH[tb]; hrun = TA[tb] * hrun + TH[tb]; float hv[4];
#pragma unroll
                    for (int i = 0; i < 4; ++i) { h = av[tb * 4 + i] * h + uv[tb * 4 + i]; hv[i] = h; }
#pragma unroll
                    for (int rg = 0; rg < 4; ++rg) XC[(tb * 16 + fq * 4 + rg) * 64 + cl] = hv[rg]; }
            } else {
#pragma unroll
                for (int tb = 3; tb >= 0; --tb) { float h = EA[tb] * hrun + EH[tb]; hrun = TA[tb] * hrun + TH[tb]; float hv[4];
#pragma unroll
                    for (int i = 3; i >= 0; --i) { h = av[tb * 4 + i] * h + uv[tb * 4 + i]; hv[i] = h; }
#pragma unroll
                    for (int rg = 0; rg < 4; ++rg) XC[(tb * 16 + fq * 4 + rg) * 64 + cl] = hv[rg]; }
            }
            __syncthreads();
            { const int t = lt >> 2, c16 = (lt & 3) * 16; float hh[16];
#pragma unroll
              for (int i = 0; i < 16; i += 4) { const f32x4v v4 = *(const f32x4v*)(XC + t * 64 + c16 + i); hh[i] = v4.x; hh[i + 1] = v4.y; hh[i + 2] = v4.z; hh[i + 3] = v4.w; }
              if (second) { const unsigned ph[8] = {pk_h[0].x, pk_h[0].y, pk_h[0].z, pk_h[0].w, pk_h[1].x, pk_h[1].y, pk_h[1].z, pk_h[1].w};
                  const unsigned pz[8] = {pk_z[0].x, pk_z[0].y, pk_z[0].z, pk_z[0].w, pk_z[1].x, pk_z[1].y, pk_z[1].z, pk_z[1].w};
#pragma unroll
                  for (int i = 0; i < 8; ++i) { hh[2 * i] = (hh[2 * i] + __uint_as_float(ph[i] << 16)) * gelu_tanh_fast(__uint_as_float(pz[i] << 16));
                      hh[2 * i + 1] = (hh[2 * i + 1] + __uint_as_float(ph[i] & 0xffff0000u)) * gelu_tanh_fast(__uint_as_float(pz[i] & 0xffff0000u)); } }
              bf16* yp = ycat + (row0 + t) * D + ch0 + c16;
              *(u32x4*)yp = (u32x4){pk2(hh[0], hh[1]), pk2(hh[2], hh[3]), pk2(hh[4], hh[5]), pk2(hh[6], hh[7])};
              *(u32x4*)(yp + 8) = (u32x4){pk2(hh[8], hh[9]), pk2(hh[10], hh[11]), pk2(hh[12], hh[13]), pk2(hh[14], hh[15])}; }
        }
    }
#undef XL_LOAD
    if (MODE == 0 && fq == 0) { float* sp = sum + (((size_t)(b * 2 + dir) * NSPAN + span) * DL + ch0 + cl) * 2; sp[0] = Ar; sp[1] = Hr; }
}
}

DEV void ph_lru_pass(const Params& P, int bid, int nb, unsigned char* lds, int mode) {
    const int vcu = (bid % 8) * (nb / 8) + bid / 8;
    const int b = vcu >> 5, n = (vcu >> 2) & 7, span = vcu & 3;
    if (mode == 0) lru::sweep2<0>(P, lds, b, n, span, bid, nb); else lru::sweep2<1>(P, lds, b, n, span, bid, nb);
}

namespace att {
typedef short s16x4 __attribute__((ext_vector_type(4)));
constexpr int KVBLK = 64, QBLK = 32, UROWS = 128;
constexpr int SHM_V = KVBLK * 128 * 2, SHM_K = KVBLK * 128 * 2;
constexpr int NVB = 3;
constexpr int LDS_WS = NVB * SHM_V + 2 * SHM_K;
constexpr int LDS_TAB = LDS_WS + 8 * 64 * 4;
constexpr int LDS_STG = LDS_TAB + 4 * 384 * 4;
constexpr int TABN = 384, TABOFF = 192;
constexpr float LOG2E = 1.4426950408889634f;
#define KSWZ(row, colB) ((row) * 256 + ((colB) ^ (((row) & 15) << 4)))
#define SBAR() __builtin_amdgcn_sched_barrier(0)
DEV int crow(int r, int hi) { return (r & 3) + 8 * (r >> 2) + 4 * hi; }
DEV unsigned cvtpk(float lo, float hi) { unsigned r; asm volatile("v_cvt_pk_bf16_f32 %0, %1, %2" : "=v"(r) : "v"(lo), "v"(hi)); return r; }
DEV void exp_half(f32x16& p) {
#pragma unroll
    for (int r = 0; r < 16; ++r) p[r] = __builtin_amdgcn_exp2f(p[r]);
}
DEV void finishSM(f32x16& p0, f32x16& p1, float& l_reg, bf16x8& pa0, bf16x8& pa1, bf16x8& pa2, bf16x8& pa3) {
    exp_half(p1);
    float ps = 0.f;
#pragma unroll
    for (int r = 0; r < 16; ++r) ps += p0[r];
#pragma unroll
    for (int r = 0; r < 16; ++r) ps += p1[r];
    l_reg += ps;
#define PK4(P, BASE, OUT) do { unsigned a0 = cvtpk(P[BASE + 0], P[BASE + 1]), a1 = cvtpk(P[BASE + 2], P[BASE + 3]);   \
    unsigned b0 = cvtpk(P[BASE + 4], P[BASE + 5]), b1 = cvtpk(P[BASE + 6], P[BASE + 7]);                              \
    auto r0 = __builtin_amdgcn_permlane32_swap(a0, b0, false, false); auto r1 = __builtin_amdgcn_permlane32_swap(a1, b1, false, false); \
    u32x4 w = {r0[0], r1[0], r0[1], r1[1]}; OUT = *reinterpret_cast<bf16x8*>(&w); } while (0)
    PK4(p0, 0, pa0); PK4(p0, 8, pa1); PK4(p1, 0, pa2); PK4(p1, 8, pa3);
#undef PK4
}
typedef int v8i __attribute__((ext_vector_type(8)));
typedef int v4i __attribute__((ext_vector_type(4)));
DEV int k8_off(int row, int chunk) { return row * 128 + ((chunk ^ ((row >> 1) & 7)) << 4); }
DEV void qkt(f32x16& p0, f32x16& p1, const char* Ks, const v8i& qf, int r32, int hi, int j, int base, const float* tl) {
    const bool nearT = (base > -154) && (base < 122);
    const int c0 = j * 4 + hi * 2;
    const v4i a00 = *reinterpret_cast<const v4i*>(Ks + k8_off(r32, c0)), a01 = *reinterpret_cast<const v4i*>(Ks + k8_off(r32, c0 + 1));
    const v4i a10 = *reinterpret_cast<const v4i*>(Ks + 4096 + k8_off(r32, c0)), a11 = *reinterpret_cast<const v4i*>(Ks + 4096 + k8_off(r32, c0 + 1));
    const v8i ka = __builtin_shufflevector(a00, a01, 0, 1, 2, 3, 4, 5, 6, 7), kb = __builtin_shufflevector(a10, a11, 0, 1, 2, 3, 4, 5, 6, 7);
    if (nearT) {
        const float* t = tl + (base - r32 + TABOFF + 4 * hi);
#pragma unroll
        for (int r = 0; r < 16; ++r) { const int ko = (r & 3) + 8 * (r >> 2); p0[r] = t[ko]; p1[r] = t[32 + ko]; }
        p0 = __builtin_amdgcn_mfma_scale_f32_32x32x64_f8f6f4(ka, qf, p0, 0, 0, 0, 0x7F7F7F7F, 0, 0x7F7F7F7F);
        p1 = __builtin_amdgcn_mfma_scale_f32_32x32x64_f8f6f4(kb, qf, p1, 0, 0, 0, 0x7F7F7F7F, 0, 0x7F7F7F7F);
    } else {
        p0 = __builtin_amdgcn_mfma_scale_f32_32x32x64_f8f6f4(ka, qf, (f32x16){}, 0, 0, 0, 0x7F7F7F7F, 0, 0x7F7F7F7F);
        p1 = __builtin_amdgcn_mfma_scale_f32_32x32x64_f8f6f4(kb, qf, (f32x16){}, 0, 0, 0, 0x7F7F7F7F, 0, 0x7F7F7F7F);
    }
}
DEV int v_st(int k, int c) { const int kk = (k & ~0xC) | ((k & 4) << 1) | ((k & 8) >> 1); return ((kk >> 3) * 4 + (c >> 5)) * 512 + ((kk & 7) * 32 + (c & 31)) * 2; }
DEV int v_rd_base(int lane) { return ((lane & 3) << 3) | (((lane >> 2) & 3) << 6) | (((lane >> 4) & 1) << 5) | (((lane >> 5) & 1) << 8); }
constexpr int v_rd_off(int d0, int ks, int half) { return d0 * 512 + ks * 4096 + half * 2048; }
template <int OFF> DEV s16x4 tr_read(int vb) { s16x4 r; asm volatile("ds_read_b64_tr_b16 %0, %1 offset:%2" : "=&v"(r) : "v"(vb), "i"(OFF) : "memory"); return r; }
template <int D0> DEV void pv_one(f32x16& od, int vb, bf16x8 pa0, bf16x8 pa1, bf16x8 pa2, bf16x8 pa3) {
    const s16x4 l0 = tr_read<v_rd_off(D0, 0, 0)>(vb), h0 = tr_read<v_rd_off(D0, 0, 1)>(vb), l1 = tr_read<v_rd_off(D0, 1, 0)>(vb), h1 = tr_read<v_rd_off(D0, 1, 1)>(vb);
    const s16x4 l2 = tr_read<v_rd_off(D0, 2, 0)>(vb), h2 = tr_read<v_rd_off(D0, 2, 1)>(vb), l3 = tr_read<v_rd_off(D0, 3, 0)>(vb), h3 = tr_read<v_rd_off(D0, 3, 1)>(vb);
    asm volatile("s_waitcnt lgkmcnt(0)" ::: "memory"); SBAR();
#define PK(L, H) (bf16x8){L[0], L[1], L[2], L[3], H[0], H[1], H[2], H[3]}
    od = __builtin_amdgcn_mfma_f32_32x32x16_bf16(pa0, PK(l0, h0), od, 0, 0, 0);
    od = __builtin_amdgcn_mfma_f32_32x32x16_bf16(pa1, PK(l1, h1), od, 0, 0, 0);
    od = __builtin_amdgcn_mfma_f32_32x32x16_bf16(pa2, PK(l2, h2), od, 0, 0, 0);
    od = __builtin_amdgcn_mfma_f32_32x32x16_bf16(pa3, PK(l3, h3), od, 0, 0, 0);
#undef PK
}
DEV void pv_d0(f32x16* o, int vb, bf16x8 pa0, bf16x8 pa1, bf16x8 pa2, bf16x8 pa3) {
    pv_one<0>(o[0], vb, pa0, pa1, pa2, pa3); pv_one<1>(o[1], vb, pa0, pa1, pa2, pa3); pv_one<2>(o[2], vb, pa0, pa1, pa2, pa3); pv_one<3>(o[3], vb, pa0, pa1, pa2, pa3);
}

DEV void attn_unit(const bf16* __restrict__ proj, const unsigned char* __restrict__ qk8, bf16* __restrict__ ycat, int b, int h, int ublk, char* lds, float fsw, float lamv, const float* __restrict__ go) {
    const int tid = phase_tid(), wid = __builtin_amdgcn_readfirstlane(tid >> 6), lane = tid & 63, r32 = lane & 31, hi = lane >> 5;
    const int qb = wid >> 1, j = wid & 1, jcb = j * 128;
    char* V_lds = lds; char* K_lds = lds + NVB * SHM_V;
    float* wsf = (float*)(lds + LDS_WS) + wid * 64;
    const float* tl = (const float*)(lds + LDS_TAB) + h * TABN;
    const long rowbase = (long)b * S;
    const int q0w = ublk * UROWS + qb * QBLK;
    float l_reg = 0.f; f32x16 o[4] = {}; v8i qr;
    { const unsigned char* Qw = qk8 + (size_t)(rowbase + q0w + r32) * 1024 + h * 128 + j * 64 + hi * 32;
      const v4i q0 = *reinterpret_cast<const v4i*>(Qw), q1 = *reinterpret_cast<const v4i*>(Qw + 16); qr = __builtin_shufflevector(q0, q1, 0, 1, 2, 3, 4, 5, 6, 7); }
    const unsigned char* Kh = qk8 + (size_t)rowbase * 1024 + 512 + h * 128; const bf16* Vh = proj + rowbase * NPROJ + 2048 + h * 128;
    const int kkey = tid >> 3, kch = tid & 7, kst = k8_off(kkey, kch);
    const int sr = tid >> 4, sc = (tid & 15) * 8, vst0 = v_st(sr, sc), vst1 = v_st(32 + sr, sc);
    const int vb0 = (int)(uintptr_t)V_lds + v_rd_base(lane);
    struct { bf16x8 vs0, vs1; v4i ks; } sr_[2];
#define SLOAD(i, k0) do { sr_[i].vs0 = *reinterpret_cast<const bf16x8*>(&Vh[(long)((k0) + sr) * NPROJ + sc]); sr_[i].vs1 = *reinterpret_cast<const bf16x8*>(&Vh[(long)((k0) + 32 + sr) * NPROJ + sc]); \
    sr_[i].ks = *reinterpret_cast<const v4i*>(Kh + (size_t)((k0) + kkey) * 1024 + kch * 16); } while (0)
#define SWRITE(kb, vbo, i) do { *(bf16x8*)(V_lds + (vbo) + vst0) = sr_[i].vs0; *(bf16x8*)(V_lds + (vbo) + vst1) = sr_[i].vs1; *(v4i*)(K_lds + (kb) * SHM_K + kst) = sr_[i].ks; } while (0)
#define SWAIT() asm volatile("s_waitcnt vmcnt(3)" ::: "memory")
    bool switched = false, pend = false;
#define CCUPD(base) do { if (!switched && (base) >= 122) { switched = true; pend = true; } } while (0)
#define RESCALE() do { if (pend) { pend = false; l_reg *= fsw; _Pragma("unroll") for (int d = 0; d < 4; ++d) _Pragma("unroll") for (int r = 0; r < 16; ++r) o[d][r] *= fsw; } } while (0)
    bf16x8 pa0, pa1, pa2, pa3; constexpr int NT = S / KVBLK;
    constexpr int SE = 0, SO = 1;
    int vrd = 0, vcur = SHM_V, vwr = 2 * SHM_V;
#define VROT() do { const int t_ = vrd; vrd = vcur; vcur = vwr; vwr = t_; } while (0)
    if (wid < 4) {
    f32x16 pA0, pA1, pB0, pB1;
    SLOAD(SE, 0); asm volatile("s_waitcnt vmcnt(0)" ::: "memory"); SWRITE(0, 0, SE); __syncthreads();
    { const int base = 0 - q0w; CCUPD(base); qkt(pA0, pA1, K_lds, qr, r32, hi, j, base, tl); } exp_half(pA0);
    SLOAD(SO, KVBLK); SLOAD(SE, 2 * KVBLK);
    SWAIT(); SWRITE(1, SHM_V, SO); __syncthreads();
    for (int jt = 1; jt + 1 < NT; jt += 2) {
        SBAR(); { const int base = jt * KVBLK - q0w; CCUPD(base); qkt(pB0, pB1, K_lds + SHM_K, qr, r32, hi, j, base, tl); }
        finishSM(pA0, pA1, l_reg, pa0, pa1, pa2, pa3); SBAR();
        SLOAD(SO, (jt + 2) * KVBLK); SBAR();
        pv_d0(o, vb0 + vrd, pa0, pa1, pa2, pa3); exp_half(pB0); RESCALE();
        SWAIT(); SWRITE(0, vwr, SE);
        __syncthreads(); VROT();
        SBAR(); { const int base = (jt + 1) * KVBLK - q0w; CCUPD(base); qkt(pA0, pA1, K_lds, qr, r32, hi, j, base, tl); }
        finishSM(pB0, pB1, l_reg, pa0, pa1, pa2, pa3); SBAR();
        if (jt + 3 < NT) SLOAD(SE, (jt + 3) * KVBLK); SBAR();
        pv_d0(o, vb0 + vrd, pa0, pa1, pa2, pa3); exp_half(pA0); RESCALE();
        SWAIT(); SWRITE(1, vwr, SO);
        __syncthreads(); VROT();
    }
    SBAR(); { const int base = (NT - 1) * KVBLK - q0w; CCUPD(base); qkt(pB0, pB1, K_lds + SHM_K, qr, r32, hi, j, base, tl); }
    finishSM(pA0, pA1, l_reg, pa0, pa1, pa2, pa3); SBAR();
    pv_d0(o, vb0 + vrd, pa0, pa1, pa2, pa3); exp_half(pB0); RESCALE();
    finishSM(pB0, pB1, l_reg, pa0, pa1, pa2, pa3); SBAR();
    pv_d0(o, vb0 + vcur, pa0, pa1, pa2, pa3);
    } else {
    f32x16 pC0, pC1;
#define RESC_NOW(base) do { if (!switched && (base) >= 122) { switched = true; l_reg *= fsw; _Pragma("unroll") for (int d = 0; d < 4; ++d) _Pragma("unroll") for (int r = 0; r < 16; ++r) o[d][r] *= fsw; } } while (0)
    SLOAD(SE, 0); asm volatile("s_waitcnt vmcnt(0)" ::: "memory"); SWRITE(0, 0, SE); __syncthreads();
    { const int base = 0 - q0w; qkt(pC0, pC1, K_lds, qr, r32, hi, j, base, tl); } exp_half(pC0); finishSM(pC0, pC1, l_reg, pa0, pa1, pa2, pa3);
    SLOAD(SO, KVBLK); SLOAD(SE, 2 * KVBLK);
    SWAIT(); SWRITE(1, SHM_V, SO); __syncthreads();
    for (int jt = 1; jt + 1 < NT; jt += 2) {
        SBAR(); SLOAD(SO, (jt + 2) * KVBLK); SBAR();
        pv_d0(o, vb0 + vrd, pa0, pa1, pa2, pa3);
        { const int base = jt * KVBLK - q0w; RESC_NOW(base); SBAR(); qkt(pC0, pC1, K_lds + SHM_K, qr, r32, hi, j, base, tl); }
        exp_half(pC0); finishSM(pC0, pC1, l_reg, pa0, pa1, pa2, pa3); SBAR();
        SWAIT(); SWRITE(0, vwr, SE);
        __syncthreads(); VROT();
        SBAR(); if (jt + 3 < NT) SLOAD(SE, (jt + 3) * KVBLK); SBAR();
        pv_d0(o, vb0 + vrd, pa0, pa1, pa2, pa3);
        { const int base = (jt + 1) * KVBLK - q0w; RESC_NOW(base); SBAR(); qkt(pC0, pC1, K_lds, qr, r32, hi, j, base, tl); }
        exp_half(pC0); finishSM(pC0, pC1, l_reg, pa0, pa1, pa2, pa3); SBAR();
        SWAIT(); SWRITE(1, vwr, SO);
        __syncthreads(); VROT();
    }
    pv_d0(o, vb0 + vrd, pa0, pa1, pa2, pa3);
    { const int base = (NT - 1) * KVBLK - q0w; RESC_NOW(base); SBAR(); qkt(pC0, pC1, K_lds + SHM_K, qr, r32, hi, j, base, tl); }
    exp_half(pC0); finishSM(pC0, pC1, l_reg, pa0, pa1, pa2, pa3); SBAR();
    pv_d0(o, vb0 + vcur, pa0, pa1, pa2, pa3);
#undef RESC_NOW
    }
#undef VROT
#undef SLOAD
#undef SWRITE
#undef SWAIT
#undef CCUPD
#undef RESCALE
    { auto rr = __builtin_amdgcn_permlane32_swap(__float_as_uint(l_reg), __float_as_uint(l_reg), false, false); l_reg = __uint_as_float(rr[0]) + __uint_as_float(rr[1]); }
    if (hi == 0) wsf[r32] = l_reg;
    asm volatile("s_waitcnt lgkmcnt(0)" ::: "memory");
    __syncthreads();
    float* X = (float*)lds + qb * 4096;
    if (j == 1) {
#pragma unroll
        for (int r = 0; r < 16; ++r) { const float sc = __builtin_amdgcn_rcpf(wsf[crow(r, hi)]) * lamv;
#pragma unroll
            for (int d0 = 0; d0 < 4; ++d0) X[(d0 * 16 + r) * 64 + lane] = o[d0][r] * sc;
            asm volatile("" ::: "memory"); }
    }
    __syncthreads();
    if (j == 0) {
        float gv[4];
#pragma unroll
        for (int d0 = 0; d0 < 4; ++d0) gv[d0] = go[32 * d0 + r32] * (1.f - LAM_INIT);
        bf16* stg = (bf16*)(lds + LDS_STG) + qb * 4096;
#pragma unroll
        for (int r = 0; r < 16; ++r) {
            const float ri = __builtin_amdgcn_rcpf(wsf[crow(r, hi)]);
            float v[4]; float ss = 0.f;
#pragma unroll
            for (int d0 = 0; d0 < 4; ++d0) { v[d0] = o[d0][r] * ri - X[(d0 * 16 + r) * 64 + lane]; ss += v[d0] * v[d0]; }
            ss += __shfl_xor(ss, 1); ss += __shfl_xor(ss, 2); ss += __shfl_xor(ss, 4); ss += __shfl_xor(ss, 8); ss += __shfl_xor(ss, 16);
            const float rs = rsqrtf(ss * (1.f / 128.f) + EPS);
            const int q = crow(r, hi);
#pragma unroll
            for (int d0 = 0; d0 < 4; ++d0) stg[q * 128 + d0 * 32 + r32] = (bf16)f2bf(v[d0] * rs * gv[d0]);
            asm volatile("" ::: "memory");
        }
        asm volatile("s_waitcnt lgkmcnt(0)" ::: "memory");
        bf16* Ow = ycat + (rowbase + q0w) * D + 512 + h * 128;
#pragma unroll
        for (int i = 0; i < 8; ++i) { const int row = i * 4 + (lane >> 4), ch = lane & 15;
            const u32x4 v = *(const u32x4*)(stg + row * 128 + ch * 8); *(u32x4*)(Ow + (long)row * D + ch * 8) = v; }
    }
    __syncthreads();
}
#undef KSWZ
#undef SBAR
}

DEV void ph_attn(const Params& P, int bid, int nb, unsigned char* lds_) {
    const int tid = phase_tid(), lane = tid & 63;
    char* lds = (char*)lds_;
    const bf16* proj = (const bf16*)(P.ws + WS_PROJ); bf16* ycat = (bf16*)(P.ws + WS_YCAT);
    const float* lq = P.in[15]; const float* go = P.in[16]; const float* rb = P.in[17];
    const float s01 = wave_sum(lq[lane] * lq[64 + lane]), s23 = wave_sum(lq[128 + lane] * lq[192 + lane]);
    const float lamv = __expf(s01) - __expf(s23) + LAM_INIT;
    __syncthreads();
    { float* tabs = (float*)(lds + att::LDS_TAB);
      for (int i = tid; i < 4 * att::TABN; i += NTHR) { const int hd = i / att::TABN, rel = i % att::TABN - att::TABOFF;
          tabs[i] = (rb[t5_bucket(rel) * NH + hd] - rb[15 * NH + hd]) * att::LOG2E; } }
    __syncthreads();
    const int vcu = (bid % 8) * (nb / 8) + bid / 8, xg = vcu >> 5, c = vcu & 31;
    for (int i = 0; i < 4; ++i) {
        const int bh = xg * 4 + i, b = bh >> 2, hd = bh & 3;
        const float fsw = __expf(rb[15 * NH + hd] - rb[31 * NH + hd]);
        att::attn_unit(proj, (const unsigned char*)(P.ws + WS_QK8), ycat, b, hd, c, lds, fsw, lamv, go);
    }
}

DEV void ph_outproj(const Params& P, int bid, int nb, unsigned char* lds) {
    pg8::StaticOrder S; S.init((const bf16*)(P.ws + WS_YCAT), (const bf16*)(P.ws + WS_WOUT), T, D, D, nb, bid);
    pg8::EpiResGate E{P.in[0], (bf16*)P.out + X1_OFF, X1_LD, (const float*)(P.ws + WS_MOD)};
    pg8::gemm_phase<pg8::EpiResGate, pg8::StaticOrder, true, false>((LAS unsigned char*)lds, D * 2, S, E);
}

DEV void ph_h2(const Params& P, int bid, int nb, unsigned char* lds) {
    const int tid = phase_tid(), lane = tid & 63, wave = tid >> 6;
    const bf16* x1 = (const bf16*)P.out + X1_OFF; const float* g2 = P.in[19]; const float* wr = P.in[20]; const float* mod = (const float*)(P.ws + WS_MOD);
    unsigned char* h2 = (unsigned char*)(P.ws + WS_H2); float* aff = (float*)(P.ws + WS_AFF);
    float* gm = (float*)lds;
    float* sh = gm + D;
    bf16x8* Whi = (bf16x8*)(lds + 8192);
    bf16x8* Wlo = Whi + 32 * 64;
    float* rsd = (float*)(lds + 8192 + 2 * 32 * 64 * 16) + wave * 16;
    for (int blk = bid; blk < T / 128; blk += nb) {
        const int b = (blk * 128) >> 12;
        __syncthreads();
        { const float* scl = mod + b * 6 * D + 4 * D; const float* shf = mod + b * 6 * D + 3 * D;
          for (int k = tid; k < D; k += NTHR) { gm[k] = g2[k] * (1.f + scl[k]); sh[k] = shf[k]; }
          for (int q = tid; q < 32 * 64; q += NTHR) { const int ks = q >> 6, l = q & 63, e = l & 15, kg = l >> 4; unsigned hi4[4], lo4[4];
#pragma unroll
              for (int jj = 0; jj < 4; ++jj) { const float w0 = wr[(size_t)(ks * 32 + kg * 8 + 2 * jj) * NE + e], w1 = wr[(size_t)(ks * 32 + kg * 8 + 2 * jj + 1) * NE + e];
                  const unsigned h0 = f2bf(w0), h1 = f2bf(w1); hi4[jj] = h0 | (h1 << 16);
                  lo4[jj] = pk2(w0 - __uint_as_float(h0 << 16), w1 - __uint_as_float(h1 << 16)); }
              const u32x4 vh = {hi4[0], hi4[1], hi4[2], hi4[3]}, vl = {lo4[0], lo4[1], lo4[2], lo4[3]};
              Whi[q] = *reinterpret_cast<const bf16x8*>(&vh); Wlo[q] = *reinterpret_cast<const bf16x8*>(&vl); } }
        __syncthreads();
        const int r0 = blk * 128 + wave * 16;
        { const int rsub = lane >> 3, ch = lane & 7; float ss0 = 0.f, ss1 = 0.f;
          const bf16* xa = x1 + (size_t)(r0 + rsub) * X1_LD + ch * 8; const bf16* xb = xa + (size_t)8 * X1_LD;
#pragma unroll 4
          for (int c = 0; c < 16; ++c) { const u32x4 va = *(const u32x4*)(xa + c * 64), vb = *(const u32x4*)(xb + c * 64);
              const unsigned wa[4] = {va.x, va.y, va.z, va.w}, wb[4] = {vb.x, vb.y, vb.z, vb.w};
#pragma unroll
              for (int i = 0; i < 4; ++i) { const float a0 = __uint_as_float(wa[i] << 16), a1 = __uint_as_float(wa[i] & 0xffff0000u), b0 = __uint_as_float(wb[i] << 16), b1 = __uint_as_float(wb[i] & 0xffff0000u);
                  ss0 += a0 * a0 + a1 * a1; ss1 += b0 * b0 + b1 * b1; } }
          ss0 += __shfl_xor(ss0, 1); ss0 += __shfl_xor(ss0, 2); ss0 += __shfl_xor(ss0, 4);
          ss1 += __shfl_xor(ss1, 1); ss1 += __shfl_xor(ss1, 2); ss1 += __shfl_xor(ss1, 4);
          if (ch == 0) { rsd[rsub] = rsqrtf(ss0 * (1.f / D) + EPS); rsd[8 + rsub] = rsqrtf(ss1 * (1.f / D) + EPS); }
          LDS_WAIT(); }
        const int row = lane & 15, kg = lane >> 4;
        const float rstd = rsd[row];
        const bf16* xr = x1 + (size_t)(r0 + row) * X1_LD + kg * 8;
        unsigned char* hr = h2 + (size_t)(r0 + row) * D + kg * 8;
        f32x4 acc = {0.f, 0.f, 0.f, 0.f};
#pragma unroll 2
        for (int ks = 0; ks < 32; ++ks) {
            const u32x4 xv = *(const u32x4*)(xr + ks * 32); const unsigned xw[4] = {xv.x, xv.y, xv.z, xv.w};
            const f32x4 g0 = *(const f32x4*)(gm + ks * 32 + kg * 8), g1 = *(const f32x4*)(gm + ks * 32 + kg * 8 + 4), s0 = *(const f32x4*)(sh + ks * 32 + kg * 8), s1 = *(const f32x4*)(sh + ks * 32 + kg * 8 + 4);
            const float gg[8] = {g0.x, g0.y, g0.z, g0.w, g1.x, g1.y, g1.z, g1.w}, ssv[8] = {s0.x, s0.y, s0.z, s0.w, s1.x, s1.y, s1.z, s1.w};
            float o[8]; unsigned hi4[4], lo4[4];
#pragma unroll
            for (int i = 0; i < 4; ++i) { o[2 * i] = __uint_as_float(xw[i] << 16) * rstd * gg[2 * i] + ssv[2 * i]; o[2 * i + 1] = __uint_as_float(xw[i] & 0xffff0000u) * rstd * gg[2 * i + 1] + ssv[2 * i + 1];
                const unsigned h0 = f2bf(o[2 * i]), h1 = f2bf(o[2 * i + 1]); hi4[i] = h0 | (h1 << 16);
                lo4[i] = pk2(o[2 * i] - __uint_as_float(h0 << 16), o[2 * i + 1] - __uint_as_float(h1 << 16)); }
            *(u32x2*)(hr + ks * 32) = (u32x2){pk4_fp8(o[0], o[1], o[2], o[3]), pk4_fp8(o[4], o[5], o[6], o[7])};
            const u32x4 vh = {hi4[0], hi4[1], hi4[2], hi4[3]}, vl = {lo4[0], lo4[1], lo4[2], lo4[3]};
            const bf16x8 ah = *reinterpret_cast<const bf16x8*>(&vh), al = *reinterpret_cast<const bf16x8*>(&vl);
            const bf16x8 bh = Whi[ks * 64 + lane], bl = Wlo[ks * 64 + lane];
            acc = __builtin_amdgcn_mfma_f32_16x16x32_bf16(ah, bh, acc, 0, 0, 0);
            acc = __builtin_amdgcn_mfma_f32_16x16x32_bf16(ah, bl, acc, 0, 0, 0);
            acc = __builtin_amdgcn_mfma_f32_16x16x32_bf16(al, bh, acc, 0, 0, 0);
        }
#pragma unroll
        for (int rg = 0; rg < 4; ++rg) { float v = acc[rg], mx = v;
            mx = fmaxf(mx, __shfl_xor(mx, 1)); mx = fmaxf(mx, __shfl_xor(mx, 2)); mx = fmaxf(mx, __shfl_xor(mx, 4)); mx = fmaxf(mx, __shfl_xor(mx, 8));
            const float pe = __expf(v - mx); float se = pe;
            se += __shfl_xor(se, 1); se += __shfl_xor(se, 2); se += __shfl_xor(se, 4); se += __shfl_xor(se, 8);
            aff[(size_t)(r0 + kg * 4 + rg) * NE + row] = pe / se; }
    }
}

DEV unsigned block_excl_scan(unsigned v, unsigned* sh  , int tid, unsigned& total) {
    const int lane = tid & 63, wave = tid >> 6;
    unsigned x = v;
#pragma unroll
    for (int o = 1; o < 64; o <<= 1) { const unsigned y = __shfl_up(x, o); if (lane >= o) x += y; }
    __syncthreads();
    if (lane == 63) sh[wave] = x;
    __syncthreads();
    unsigned base = 0, tot = 0;
#pragma unroll
    for (int w = 0; w < NWAVE; ++w) { const unsigned s = sh[w]; if (w < wave) base += s; tot += s; }
    total = tot;
    return base + x - v;
}
DEV void topk_be(const Params& P, const int b, const int e, const int pm, unsigned char* lds, LAS int* rowtab, LAS float* gvtab) {
    const int tid = phase_tid();
    const float* aff = (const float*)(P.ws + WS_AFF);
    int* sel = (int*)(P.ws + WS_SEL);
    unsigned* hist = (unsigned*)lds;
    unsigned* sh = hist + 1024;
    unsigned* sh2 = sh + 16;
    {
        unsigned key[8];
#pragma unroll
        for (int i = 0; i < 8; ++i) key[i] = __float_as_uint(aff[((size_t)b * S + tid * 8 + i) * NE + e]);
        unsigned prefix = 0, krem = CAP;
#pragma unroll
        for (int pass = 0; pass < 3; ++pass) {
            const int shift = 20 - 10 * pass;
            __syncthreads();
            hist[tid] = 0u; hist[tid + 512] = 0u;
            __syncthreads();
#pragma unroll
            for (int i = 0; i < 8; ++i) { const bool in = (pass == 0) || ((key[i] >> (shift + 10)) == (prefix >> (shift + 10))); if (in) atomicAdd(&hist[(key[i] >> shift) & 1023u], 1u); }
            __syncthreads();
            if (tid < 64) {
                const int l = tid; unsigned c16[16]; unsigned s_ = 0;
#pragma unroll
                for (int q = 0; q < 16; ++q) { c16[q] = hist[1023 - 16 * l - q]; s_ += c16[q]; }
                unsigned inc = s_;
#pragma unroll
                for (int o = 1; o < 64; o <<= 1) { const unsigned y = __shfl_up(inc, o); if (l >= o) inc += y; }
                const unsigned exc = inc - s_;
                if (exc < krem && inc >= krem) { unsigned cum = exc; int binsel = 0; unsigned kr = krem;
#pragma unroll
                    for (int q = 0; q < 16; ++q) { if (cum < krem && cum + c16[q] >= krem) { binsel = 1023 - 16 * l - q; kr = krem - cum; } cum += c16[q]; }
                    sh2[0] = (unsigned)binsel; sh2[1] = kr; }
            }
            __syncthreads();
            prefix |= sh2[0] << shift; krem = sh2[1];
        }
        unsigned ng = 0, neq = 0;
#pragma unroll
        for (int i = 0; i < 8; ++i) { ng += key[i] > prefix ? 1u : 0u; neq += key[i] == prefix ? 1u : 0u; }
        unsigned tot;
        const unsigned eqbase = block_excl_scan(neq, sh, tid, tot);
        unsigned nsel = 0; unsigned selmask = 0; unsigned er = eqbase;
#pragma unroll
        for (int i = 0; i < 8; ++i) { bool s_ = key[i] > prefix; if (key[i] == prefix) { s_ = er < krem; ++er; } if (s_) { selmask |= 1u << i; ++nsel; } }
        unsigned pos = block_excl_scan(nsel, sh, tid, tot);
        int* selp = sel + ((size_t)(b * NE + e)) * S + tid * 8;
        const bool mine = (tid >> 8) == pm;
        int sv[8];
#pragma unroll
        for (int i = 0; i < 8; ++i) {
            if (selmask & (1u << i)) { const unsigned lp = pos - (unsigned)pm * 256u; if (lp < 256u) { rowtab[lp] = tid * 8 + i; gvtab[lp] = __uint_as_float(key[i]); } sv[i] = (int)pos; ++pos; }
            else sv[i] = -1;
        }
        if (mine) { *(i32x4*)selp = (i32x4){sv[0], sv[1], sv[2], sv[3]}; *(i32x4*)(selp + 4) = (i32x4){sv[4], sv[5], sv[6], sv[7]}; }
    }
    __syncthreads();
}

DEV void ph_moe_up(const Params& P, int bid, int nb, unsigned char* lds) {
    const int vcu = (bid % 8) * (nb / 8) + bid / 8;
    pg8::MoeUpOrder S; S.e = vcu >> 4; S.b = (vcu & 15) >> 1; S.pm = vcu & 1; S.g = S.b * NE + S.e;
    S.h2 = (const char*)(P.ws + WS_H2); S.w1 = (const char*)(P.ws + WS_W1); S.w3 = (const char*)(P.ws + WS_W3);
    LAS int* rowtab = (LAS int*)((LAS unsigned char*)lds + LDS_MISC + 1024);
    LAS float* gvtab = (LAS float*)((LAS unsigned char*)lds + LDS_MISC + 2048);
    __syncthreads();
    topk_be(P, S.b, S.e, S.pm, lds, rowtab, gvtab);
    S.rowtab = rowtab;
    pg8::EpiSwiGLU E{(unsigned char*)(P.ws + WS_HB), gvtab};
    pg8::gemm_phase<pg8::EpiSwiGLU, pg8::MoeUpOrder, true, true, true>((LAS unsigned char*)lds, D, S, E);
}

DEV void ph_moe_down(const Params& P, int bid, int nb, unsigned char* lds) {
    const int vcu = (bid % 8) * (nb / 8) + bid / 8;
    pg8::MoeDownOrder S; S.e = vcu >> 4; S.pm = vcu & 1; S.g = ((vcu & 15) >> 1) * NE + S.e;
    S.hb = (const char*)(P.ws + WS_HB); S.w2 = (const char*)(P.ws + WS_W2);
    pg8::EpiScaleRow E{(unsigned char*)(P.ws + WS_YB)};
    pg8::gemm_phase<pg8::EpiScaleRow, pg8::MoeDownOrder, true, false, true>((LAS unsigned char*)lds, D, S, E);
}

DEV void ph_final(const Params& P, int bid, int nb, bool probe = false) {
    const int tid = phase_tid(), lane = tid & 63, wave = tid >> 6;
    const float* mod = (const float*)(P.ws + WS_MOD); const int* sel = (const int*)(P.ws + WS_SEL); const unsigned char* yb = (const unsigned char*)(P.ws + WS_YB);
    float* out = P.out; float* dst = probe ? (float*)(P.ws + WS_PROJ) : P.out;
    const int gw = bid * NWAVE + wave, ngw = nb * NWAVE;
    for (int row0 = gw; row0 < T; row0 += 2 * ngw) {
        const int rowA = row0, rowB = row0 + ngw < T ? row0 + ngw : row0; const bool hasB = row0 + ngw < T;
        const int bA = rowA >> 12, bB = rowB >> 12;
        u32x2 xa[4], xb[4];
#pragma unroll
        for (int j = 0; j < 4; ++j) { xa[j] = ((const u32x2*)((const bf16*)out + (size_t)rowA * X1_LD + X1_OFF) + lane)[64 * j]; xb[j] = ((const u32x2*)((const bf16*)out + (size_t)rowB * X1_LD + X1_OFF) + lane)[64 * j]; }
        const int e16 = lane & 15;
        const int cA = sel[((size_t)(bA * NE + e16)) * S + (rowA & (S - 1))], cB = sel[((size_t)(bB * NE + e16)) * S + (rowB & (S - 1))];
        unsigned mA = (unsigned)(__ballot(cA >= 0) & 0xFFFFull), mB = (unsigned)(__ballot(cB >= 0) & 0xFFFFull);
        float accA[16], accB[16];
#pragma unroll
        for (int i = 0; i < 16; ++i) { accA[i] = 0.f; accB[i] = 0.f; }
#define ACCROW(ACC, M, CV, BB) do { while (M) { const int e0 = __builtin_ctz(M); M &= M - 1; const int c0 = __builtin_amdgcn_readlane(CV, e0); \
            int e1 = -1, c1 = 0; if (M) { e1 = __builtin_ctz(M); M &= M - 1; c1 = __builtin_amdgcn_readlane(CV, e1); } \
            const unsigned char* y0 = yb + ((size_t)((BB) * NE + e0) * CAP + c0) * D; const unsigned char* y1 = yb + ((size_t)((BB) * NE + (e1 < 0 ? e0 : e1)) * CAP + (e1 < 0 ? c0 : c1)) * D; \
            int w0[4], w1[4]; \
            _Pragma("unroll") for (int j = 0; j < 4; ++j) { w0[j] = *(const int*)(y0 + 4 * lane + 256 * j); w1[j] = *(const int*)(y1 + 4 * lane + 256 * j); } \
            const float f1 = e1 < 0 ? 0.f : 1.f; \
            _Pragma("unroll") for (int j = 0; j < 4; ++j) { \
                const f32x2 p0 = __builtin_amdgcn_cvt_pk_f32_fp8(w0[j], false), p1 = __builtin_amdgcn_cvt_pk_f32_fp8(w0[j], true), q0 = __builtin_amdgcn_cvt_pk_f32_fp8(w1[j], false), q1 = __builtin_amdgcn_cvt_pk_f32_fp8(w1[j], true); \
                ACC[4 * j] += p0.x + f1 * q0.x; ACC[4 * j + 1] += p0.y + f1 * q0.y; ACC[4 * j + 2] += p1.x + f1 * q1.x; ACC[4 * j + 3] += p1.y + f1 * q1.y; } } } while (0)
        ACCROW(accA, mA, cA, bA);
        if (hasB) ACCROW(accB, mB, cB, bB);
#undef ACCROW
        const float* gA = mod + bA * 6 * D + 5 * D; const float* gB = mod + bB * 6 * D + 5 * D;
#pragma unroll
        for (int j = 0; j < 4; ++j) { const int k = 4 * lane + 256 * j; const f32x4 g = *(const f32x4*)(gA + k) * 0.03125f;
            f32x4 v = {__uint_as_float(xa[j].x << 16), __uint_as_float(xa[j].x & 0xffff0000u), __uint_as_float(xa[j].y << 16), __uint_as_float(xa[j].y & 0xffff0000u)};
            v.x += g.x * accA[4 * j]; v.y += g.y * accA[4 * j + 1]; v.z += g.z * accA[4 * j + 2]; v.w += g.w * accA[4 * j + 3]; *(f32x4*)(dst + (size_t)rowA * D + k) = v; }
        if (hasB) {
#pragma unroll
            for (int j = 0; j < 4; ++j) { const int k = 4 * lane + 256 * j; const f32x4 g = *(const f32x4*)(gB + k) * 0.03125f;
                f32x4 v = {__uint_as_float(xb[j].x << 16), __uint_as_float(xb[j].x & 0xffff0000u), __uint_as_float(xb[j].y << 16), __uint_as_float(xb[j].y & 0xffff0000u)};
                v.x += g.x * accB[4 * j]; v.y += g.y * accB[4 * j + 1]; v.z += g.z * accB[4 * j + 2]; v.w += g.w * accB[4 * j + 3]; *(f32x4*)(dst + (size_t)rowB * D + k) = v; }
        }
    }
}

constexpr int NPHASE = 11;
template <int PH> DEV void run_phase(const Params& P, int bid, int nb, unsigned char* lds) {
    if constexpr (PH == 0) ph_mod(P, bid, nb, lds);
    if constexpr (PH == 1) { ph_h(P, bid, nb); ph_prep(P, bid, nb, lds); }
    if constexpr (PH == 2) ph_inproj(P, bid, nb, lds);
    if constexpr (PH == 3) ph_lru_pass(P, bid, nb, lds, 0);
    if constexpr (PH == 4) { ph_lru_pass(P, bid, nb, lds, 1); ph_attn(P, bid, nb, lds); }
    if constexpr (PH == 5) ph_outproj(P, bid, nb, lds);
    if constexpr (PH == 6) ph_h2(P, bid, nb, lds);
    if constexpr (PH == 8) ph_moe_up(P, bid, nb, lds);
    if constexpr (PH == 9) ph_moe_down(P, bid, nb, lds);
    if constexpr (PH == 10) ph_final(P, bid, nb);
    if constexpr (PH == 20) ph_lru_pass(P, bid, nb, lds, 0);
    if constexpr (PH == 21) ph_lru_pass(P, bid, nb, lds, 1);
    if constexpr (PH == 22) ph_attn(P, bid, nb, lds);
    if constexpr (PH == 23) ph_qknorm_conv(P, bid, nb, true);
    if constexpr (PH == 24) ph_final(P, bid, nb, true);
}
#if MK_SINGLE
__global__ void __launch_bounds__(NTHR, 2) mega(Params P) {
    extern __shared__ __attribute__((aligned(16))) unsigned char lds[];
    const int bid = blockIdx.x, nb = gridDim.x;
    volatile LAS unsigned* MISC = (volatile LAS unsigned*)((LAS unsigned char*)lds + LDS_MISC);
    tid_table_init();
    for (int u = threadIdx.x; u < 64; u += NTHR) MISC[u] = 0u;
    __syncthreads();
    (void)xcd_barrier_post((unsigned*)(P.ws + WS_CTL) + 4096, MISC + 8);
#define SEAM() do { XcdBarrier bar_; bar_.bar = (unsigned*)(P.ws + WS_CTL) + 4096; bar_.x = xb_xcc_id(); \
        bar_.st = (volatile LAS unsigned*)((LAS unsigned char*)lds + LDS_MISC) + 8; xcd_barrier(bar_); } while (0)
    run_phase<0>(P, bid, nb, lds); SEAM();
    run_phase<1>(P, bid, nb, lds); SEAM();
    run_phase<2>(P, bid, nb, lds); SEAM();
    run_phase<3>(P, bid, nb, lds); SEAM();
    run_phase<4>(P, bid, nb, lds); SEAM();
    run_phase<5>(P, bid, nb, lds); SEAM();
    run_phase<6>(P, bid, nb, lds); SEAM();
    run_phase<8>(P, bid, nb, lds); SEAM();
    run_phase<9>(P, bid, nb, lds); SEAM();
#undef SEAM
    run_phase<10>(P, bid, nb, lds);
}
#else
template <int PH> __global__ void __launch_bounds__(NTHR, 2) phase_kernel(Params P) {
    extern __shared__ __attribute__((aligned(16))) unsigned char lds[];
    tid_table_init(); __syncthreads();
    run_phase<PH>(P, blockIdx.x, gridDim.x, lds);
}
#ifndef PROBE_PH
#define PROBE_PH -1
#endif
#ifndef PROBE_REP
#define PROBE_REP 1
#endif
template <int PH> static void launch_phase(int grid, hipStream_t stream, const Params& p) {
    static bool attr = false;
    if (!attr) { (void)hipFuncSetAttribute((const void*)phase_kernel<PH>, hipFuncAttributeMaxDynamicSharedMemorySize, LDS_BYTES); attr = true; }
    hipLaunchKernelGGL(phase_kernel<PH>, dim3(grid), dim3(NTHR), LDS_BYTES, stream, p);
    if (PROBE_PH == PH) for (int r = 0; r < PROBE_REP; ++r) hipLaunchKernelGGL(phase_kernel<PH>, dim3(grid), dim3(NTHR), LDS_BYTES, stream, p);
    if (PH == 3 && PROBE_PH == 20) for (int r = 0; r < PROBE_REP; ++r) hipLaunchKernelGGL(phase_kernel<20>, dim3(grid), dim3(NTHR), LDS_BYTES, stream, p);
    if (PH == 4 && PROBE_PH == 21) for (int r = 0; r < PROBE_REP; ++r) hipLaunchKernelGGL(phase_kernel<21>, dim3(grid), dim3(NTHR), LDS_BYTES, stream, p);
    if (PH == 4 && PROBE_PH == 22) for (int r = 0; r < PROBE_REP; ++r) hipLaunchKernelGGL(phase_kernel<22>, dim3(grid), dim3(NTHR), LDS_BYTES, stream, p);
    if (PH == 3 && PROBE_PH == 23) for (int r = 0; r < PROBE_REP; ++r) hipLaunchKernelGGL(phase_kernel<23>, dim3(grid), dim3(NTHR), LDS_BYTES, stream, p);
    if (PH == 9 && PROBE_PH == 24) for (int r = 0; r < PROBE_REP; ++r) hipLaunchKernelGGL(phase_kernel<24>, dim3(grid), dim3(NTHR), LDS_BYTES, stream, p);
}
#endif

extern "C" void kernel_launch(void* const* d_in, const int* in_sizes, int n_in, void* d_out, int out_size, void* d_ws, size_t ws_size, hipStream_t stream) {
    static int grid = 0;
    if (grid == 0) {
        if (n_in != 24 || out_size != T * D || ws_size < WS_END) { fprintf(stderr, "kernel_launch: unexpected shapes (n_in %d out %d ws %zu)\n", n_in, out_size, ws_size); grid = -1; return; }
        int dev = 0, cus = 0;
        if (hipGetDevice(&dev) != hipSuccess || hipDeviceGetAttribute(&cus, hipDeviceAttributeMultiprocessorCount, dev) != hipSuccess) { grid = -1; return; }
#if MK_SINGLE
        if (hipFuncSetAttribute((const void*)mega, hipFuncAttributeMaxDynamicSharedMemorySize, LDS_BYTES) != hipSuccess) { fprintf(stderr, "kernel_launch: hipFuncSetAttribute failed\n"); grid = -1; return; }
        int per_cu = 0;
        (void)hipOccupancyMaxActiveBlocksPerMultiprocessor(&per_cu, (const void*)mega, NTHR, LDS_BYTES);
        (void)hipGetLastError();
#endif
        grid = cus;
        if (grid != 256) { fprintf(stderr, "kernel_launch: this build needs a 256-CU device (got %d)\n", cus); grid = -1; return; }
    }
    if (grid < 0) return;
    (void)hipMemsetAsync((char*)d_ws + WS_CTL, 0, 1 * MiB, stream);
    Params p{};
    for (int i = 0; i < 24; ++i) p.in[i] = (const float*)d_in[i];
    p.out = (float*)d_out; p.ws = (unsigned char*)d_ws;
#if MK_SINGLE
    hipLaunchKernelGGL(mega, dim3(grid), dim3(NTHR), LDS_BYTES, stream, p);
#else
    launch_phase<0>(grid, stream, p); launch_phase<1>(grid, stream, p); launch_phase<2>(grid, stream, p); launch_phase<3>(grid, stream, p);
    launch_phase<4>(grid, stream, p); launch_phase<5>(grid, stream, p); launch_phase<6>(grid, stream, p); launch_phase<7>(grid, stream, p);
    launch_phase<8>(grid, stream, p); launch_phase<9>(grid, stream, p); launch_phase<10>(grid, stream, p);
#endif
}
```

```cpp
#include <hip/hip_runtime.h>
#include <cstdint>
#include <cstdio>

#ifndef MK_SINGLE
#define MK_SINGLE 1
#endif

#define DEV __device__ __forceinline__
#define GAS __attribute__((address_space(1)))
#define LAS __attribute__((address_space(3)))
typedef unsigned short bf16;
typedef short bf16x8 __attribute__((ext_vector_type(8)));
typedef float f32x16 __attribute__((ext_vector_type(16)));
typedef float f32x4 __attribute__((ext_vector_type(4)));
typedef unsigned u32x4 __attribute__((ext_vector_type(4)));
typedef int i32x4 __attribute__((ext_vector_type(4)));
typedef float f32x2 __attribute__((ext_vector_type(2)));
typedef unsigned u32x2 __attribute__((ext_vector_type(2)));

constexpr int NB = 8, S = 4096, D = 1024, T = NB * S;
constexpr int DL = 512, NPROJ = 2560, NE = 16, CAP = 512, NH = 4;
constexpr float EPS = 1e-6f;
constexpr float LAM_INIT = 0.2f;
constexpr int NTHR = 512, NWAVE = 8;

constexpr size_t MiB = 1u << 20;
constexpr size_t WS_PROJ = 0;
constexpr size_t WS_HB = 0;
constexpr size_t WS_H = 160 * MiB;
constexpr size_t WS_XCG = 160 * MiB;
constexpr size_t WS_AF = 160 * MiB;
constexpr size_t WS_YB = 160 * MiB;
constexpr size_t WS_YCAT = 224 * MiB;
constexpr size_t WS_XC = 224 * MiB;
constexpr size_t WS_H2 = 288 * MiB;
constexpr size_t WS_UF = 288 * MiB;
constexpr size_t WS_QK8 = 288 * MiB;
constexpr size_t WS_WIN = 352 * MiB;
constexpr size_t WS_WOUT = 357 * MiB;
constexpr size_t WS_W1 = 360 * MiB;
constexpr size_t WS_W3 = 392 * MiB;
constexpr size_t WS_W2 = 424 * MiB;
constexpr size_t WS_CTL = 456 * MiB;
constexpr size_t WS_MOD = 457 * MiB;
constexpr size_t WS_AFF = 458 * MiB;
constexpr size_t WS_IDX = 460 * MiB;
constexpr size_t WS_GVAL = 460 * MiB + 512 * 1024;
constexpr size_t WS_SEL = 461 * MiB;
constexpr size_t WS_BIAS = 463 * MiB;
constexpr size_t WS_LSUM = 463 * MiB + 512 * 1024;
constexpr size_t WS_END = 464 * MiB;

constexpr int X1_LD = 2048, X1_OFF = 1024;
struct Params { const float* in[24]; float* out; unsigned char* ws; };

DEV float bf2f(bf16 v) { return __uint_as_float((unsigned)v << 16); }
DEV unsigned f2bf(float f) { unsigned u = __float_as_uint(f); return (u + 0x7fffu + ((u >> 16) & 1u)) >> 16; }
DEV unsigned pk2(float lo, float hi) { return f2bf(lo) | (f2bf(hi) << 16); }
DEV float wave_sum(float v) {
#pragma unroll
    for (int o = 1; o < 64; o <<= 1) v += __shfl_xor(v, o);
    return v;
}
DEV float sigmoidf_(float x) { return 1.f / (1.f + __expf(-x)); }
DEV float siluf_(float x) { return x / (1.f + __expf(-x)); }
DEV float gelu_tanh(float x) { const float u = 0.7978845608028654f * (x + 0.044715f * x * x * x); return 0.5f * x * (1.f + tanhf(u)); }
DEV float clamp_f8(float v) { return __builtin_amdgcn_fmed3f(v, -448.f, 448.f); }
DEV unsigned pk4_fp8(float a, float b, float c, float d) { int p = 0; p = __builtin_amdgcn_cvt_pk_fp8_f32(clamp_f8(a), clamp_f8(b), p, false); p = __builtin_amdgcn_cvt_pk_fp8_f32(clamp_f8(c), clamp_f8(d), p, true); return (unsigned)p; }
#define LDS_WAIT() asm volatile("s_waitcnt lgkmcnt(0)" ::: "memory")
constexpr int LDS_TIDTAB = 131072 + 12288;
DEV unsigned hw_wave_key() { return (unsigned)__builtin_amdgcn_s_getreg((5 << 11) | 4) & 63u; }
DEV int lane_id() { return (int)__builtin_amdgcn_mbcnt_hi(~0u, __builtin_amdgcn_mbcnt_lo(~0u, 0u)); }
DEV void tid_table_init() { if (lane_id() == 0) ((volatile LAS unsigned*)LDS_TIDTAB)[hw_wave_key()] = threadIdx.x; }
DEV int phase_tid() { int t = (int)((volatile LAS unsigned*)LDS_TIDTAB)[hw_wave_key()] + lane_id(); asm volatile("" : "+v"(t)); return t; }

#define XB_TMO      128
#define XB_XCNT(j)  (256  + 64 * (j))
#define XB_XSUB(j)  (1280 + 64 * (j))
#define XB_XGEN(j)  (2304 + 64 * (j))
#define XB_TOP      3328
#define XB_TOPGEN   3392
#define XCD_BAR_WORDS 3456
#define XB_SPIN_CAP (1u << 22)
DEV unsigned xb_ld(unsigned* p)              { return __hip_atomic_load(p, __ATOMIC_RELAXED, __HIP_MEMORY_SCOPE_AGENT); }
DEV unsigned xb_add(unsigned* p, unsigned v) { return __hip_atomic_fetch_add(p, v, __ATOMIC_RELAXED, __HIP_MEMORY_SCOPE_AGENT); }
DEV unsigned xb_xcc_id() { return (unsigned)__builtin_amdgcn_s_getreg((3 << 11) | 20) & 0xFu; }
#define XB_SPIN(cond, bar) do { unsigned _sp = 0; while (cond) { __builtin_amdgcn_s_sleep(1); \
    if ((++_sp & 255u) == 0u) { if (xb_ld(&(bar)[XB_TMO])) break; if (_sp > XB_SPIN_CAP) { atomicAdd(&(bar)[XB_TMO], 1u); break; } } } } while (0)
struct XcdBarrier { unsigned* bar; unsigned x; volatile LAS unsigned* st; unsigned G; };
DEV XcdBarrier xcd_barrier_post(unsigned* bar, volatile LAS unsigned* st) {
    XcdBarrier b; b.bar = bar; b.x = xb_xcc_id(); b.st = st; b.G = 0u;
    if (threadIdx.x == 0) (void)xb_add(&bar[XB_XCNT(b.x)], 1u);
    return b;
}
DEV void xcd_barrier_complete(unsigned* bar, unsigned x, unsigned& nloc, unsigned& nx, const unsigned G) {
    unsigned sum, cnt, mine, sp = 0u;
    for (;;) {
        sum = 0u; cnt = 0u; mine = 0u;
#pragma unroll
        for (unsigned j = 0; j < 16; ++j) { const unsigned c = xb_ld(&bar[XB_XCNT(j)]); sum += c; cnt += (c > 0u) ? 1u : 0u; mine = (j == x) ? c : mine; }
        if (sum == G) break;
        __builtin_amdgcn_s_sleep(1);
        if ((++sp & 255u) == 0u) { if (xb_ld(&bar[XB_TMO])) break; if (sp > XB_SPIN_CAP) { atomicAdd(&bar[XB_TMO], 1u); break; } }
    }
    nloc = mine > 0u ? mine : 1u; nx = cnt > 0u ? cnt : 1u;
}
DEV void xcd_barrier(const XcdBarrier& b) {
    asm volatile("s_waitcnt vmcnt(0)" ::: "memory");
    __syncthreads();
    if (phase_tid() == 0) {
        unsigned* bar = b.bar;
        __builtin_amdgcn_s_waitcnt(0);
        unsigned nloc = b.st[0], nx = b.st[1];
        if (nloc == 0u) { xcd_barrier_complete(bar, b.x, nloc, nx, b.G); b.st[0] = nloc; b.st[1] = nx; }
        const bool light = b.G < gridDim.x && nx == 1u;
        const unsigned old = xb_add(&bar[XB_XSUB(b.x)], 1u);
        const unsigned gen = old / nloc;
        if (old + 1u == (gen + 1u) * nloc) {
            if (!light) __builtin_amdgcn_fence(__ATOMIC_RELEASE, "agent");
            asm volatile("s_waitcnt vmcnt(0)" ::: "memory");
            const unsigned og = xb_add(&bar[XB_TOP], 1u);
            const unsigned tg = og / nx;
            if (og + 1u == (tg + 1u) * nx) xb_add(&bar[XB_TOPGEN], 1u);
            else XB_SPIN(xb_ld(&bar[XB_TOPGEN]) == tg, bar);
            if (light) asm volatile("buffer_inv sc0" ::: "memory"); else __builtin_amdgcn_fence(__ATOMIC_ACQUIRE, "agent");
            xb_add(&bar[XB_XGEN(b.x)], 1u);
            asm volatile("s_waitcnt vmcnt(0)" ::: "memory");
        } else {
            XB_SPIN(xb_ld(&bar[XB_XGEN(b.x)]) == gen, bar);
            if (light) asm volatile("buffer_inv sc0" ::: "memory"); else __builtin_amdgcn_fence(__ATOMIC_ACQUIRE, "agent");
            asm volatile("s_waitcnt vmcnt(0)" ::: "memory");
        }
    }
    __syncthreads();
}

constexpr int LDS_SCRATCH = 0;
constexpr int LDS_MISC = 131072;
constexpr int LDS_BYTES = 147456;

DEV void transpose_item(const float* W, int K, int N, bf16* WT, float* scr, int item, int lane) {
    const int nblk = N / 32, kb = item / nblk, nbk = item % nblk, k0 = 64 * kb, n0 = 32 * nbk;
#pragma unroll 8
    for (int i = 0; i < 32; ++i) { const int kk = 2 * i + (lane >> 5); scr[kk * 33 + (lane & 31)] = W[(size_t)(k0 + kk) * N + n0 + (lane & 31)]; }
    LDS_WAIT();
    const int c = lane & 7;
#pragma unroll
    for (int j = 0; j < 4; ++j) { const int n = (lane >> 3) + 8 * j; const float* s = scr + (8 * c) * 33 + n;
        u32x4 o; o.x = pk2(s[0 * 33], s[1 * 33]); o.y = pk2(s[2 * 33], s[3 * 33]); o.z = pk2(s[4 * 33], s[5 * 33]); o.w = pk2(s[6 * 33], s[7 * 33]);
        *(u32x4*)(WT + (size_t)(n0 + n) * K + k0 + 8 * c) = o; }
    LDS_WAIT();
}
DEV void transpose_item_f8(const float* W, int K, int N, unsigned char* WT, float* scr, int item, int lane) {
    const int nblk = N / 32, kb = item / nblk, nbk = item % nblk, k0 = 64 * kb, n0 = 32 * nbk;
#pragma unroll 8
    for (int i = 0; i < 32; ++i) { const int kk = 2 * i + (lane >> 5); scr[kk * 33 + (lane & 31)] = W[(size_t)(k0 + kk) * N + n0 + (lane & 31)]; }
    LDS_WAIT();
    const int c = lane & 7;
#pragma unroll
    for (int j = 0; j < 4; ++j) { const int n = (lane >> 3) + 8 * j; const float* s = scr + (8 * c) * 33 + n;
        int p0 = 0, p1 = 0;
        p0 = __builtin_amdgcn_cvt_pk_fp8_f32(s[0 * 33], s[1 * 33], p0, false); p0 = __builtin_amdgcn_cvt_pk_fp8_f32(s[2 * 33], s[3 * 33], p0, true);
        p1 = __builtin_amdgcn_cvt_pk_fp8_f32(s[4 * 33], s[5 * 33], p1, false); p1 = __builtin_amdgcn_cvt_pk_fp8_f32(s[6 * 33], s[7 * 33], p1, true);
        *(u32x2*)(WT + (size_t)(n0 + n) * K + k0 + 8 * c) = (u32x2){(unsigned)p0, (unsigned)p1}; }
    LDS_WAIT();
}
DEV int t5_bucket(int rel) {
    const int ret = rel > 0 ? 16 : 0; const int n = rel < 0 ? -rel : rel;
    if (n < 8) return ret + n;
    const int l2 = 31 - __clz(n * n);
    int large = 8 + l2 - 6; if (large > 15) large = 15;
    return ret + large;
}
DEV void ph_mod(const Params& P, int bid, int nb, unsigned char* lds) {
    const int tid = phase_tid(), lane = tid & 63, wave = tid >> 6;
    float* sc = (float*)lds;
    float* red = (float*)lds + 8 * 1024;
    const float* c = P.in[1]; const float* wm = P.in[2]; const float* bm = P.in[3];
    float* mod = (float*)(P.ws + WS_MOD);
    __syncthreads();
    for (int i = tid; i < NB * D; i += NTHR) sc[i] = siluf_(c[i]);
    __syncthreads();
    constexpr int CPB = 24;
    for (int it = bid; it < 6 * D / CPB; it += nb) {
        const int j0 = it * CPB, cg = lane % 6, kr = lane / 6;
        f32x4 acc[8];
#pragma unroll
        for (int b = 0; b < 8; ++b) acc[b] = (f32x4){0.f, 0.f, 0.f, 0.f};
        if (kr < 10) {
            const float* wp = wm + (size_t)(wave * 128 + kr) * (6 * D) + j0 + 4 * cg;
            f32x4 wv[13];
#pragma unroll
            for (int i = 0; i < 13; ++i) wv[i] = (i < 12 || kr < 8) ? *(const f32x4*)(wp + (size_t)(10 * i) * (6 * D)) : (f32x4){0.f, 0.f, 0.f, 0.f};
            const LAS float* scl = (const LAS float*)(LAS unsigned char*)lds + wave * 128 + (kr < 8 ? kr : kr - 10);
            asm volatile("" : "+v"(scl));
#pragma unroll
            for (int i = 0; i < 13; ++i) {
#pragma unroll
                for (int b = 0; b < 8; ++b) { const float sv = scl[b * D + 10 * i + (kr < 8 ? 0 : 10) * (i < 12 ? 1 : 0)]; acc[b] += wv[i] * sv; }
                if ((i & 1) == 1) asm volatile("" ::: "memory"); }
#pragma unroll
            for (int b = 0; b < 8; ++b) *(f32x4*)(red + ((wave * 10 + kr) * 8 + b) * CPB + 4 * cg) = acc[b];
        }
        __syncthreads();
        if (tid < 8 * CPB) { float s_ = 0.f;
#pragma unroll 8
            for (int p_ = 0; p_ < 80; ++p_) s_ += red[p_ * (8 * CPB) + tid];
            const int b = tid / CPB, cc = tid % CPB;
            mod[b * (6 * D) + j0 + cc] = s_ + bm[j0 + cc]; }
        __syncthreads();
    }
}
constexpr int PREP2_IOUT_C = (D / 64) * (D / 32);
DEV void ph_prep(const Params& P, int bid, int nb, unsigned char* lds) {
    const int tid = phase_tid(), lane = tid & 63, wave = tid >> 6;
    float* scr = (float*)lds + wave * (64 * 33);
    const int gw = bid * NWAVE + wave, ngw = nb * NWAVE;
    constexpr int I_IN = (D / 64) * (NPROJ / 32);
    for (int it = gw; it < I_IN; it += ngw) transpose_item(P.in[5], D, NPROJ, (bf16*)(P.ws + WS_WIN), scr, it, lane);
    for (int it = gw - I_IN; it >= 0 && it < PREP2_IOUT_C; it += ngw) transpose_item(P.in[18], D, D, (bf16*)(P.ws + WS_WOUT), scr, it, lane);
}
constexpr int PREP2_IOUT = (D / 64) * (D / 32), PREP2_IE = (D / 64) * (D / 32), PREP2_NIT = PREP2_IOUT + 3 * NE * PREP2_IE;
struct Prep2Item { const float* src; unsigned char* dst; int k0, n0; bool f8; };
DEV bool prep2_decode(const Params& P, int it, Prep2Item& pi) {
    if (it >= PREP2_NIT) return false;
    int r = it;
    if (r < PREP2_IOUT) { pi.src = P.in[18]; pi.dst = P.ws + WS_WOUT; pi.f8 = false; }
    else { r -= PREP2_IOUT; const int which = r / (NE * PREP2_IE); r -= which * (NE * PREP2_IE); const int e = r / PREP2_IE; r -= e * PREP2_IE;
        pi.src = P.in[which == 0 ? 21 : (which == 1 ? 22 : 23)] + (size_t)e * D * D; pi.dst = P.ws + (which == 0 ? WS_W1 : (which == 1 ? WS_W3 : WS_W2)) + (size_t)e * D * D; pi.f8 = true; }
    pi.k0 = 64 * (r / (D / 32)); pi.n0 = 32 * (r % (D / 32)); return true;
}
DEV void prep2_load(const Prep2Item& pi, int lane, float (&tv)[32]) {
    const float* sp = pi.src + (size_t)(pi.k0 + 32 * (lane >> 5)) * D + pi.n0 + (lane & 31);
#pragma unroll
    for (int i = 0; i < 32; ++i) tv[i] = __builtin_nontemporal_load(sp + (size_t)i * D);
}
DEV void prep2_finish(const Prep2Item& pi, int lane, const float (&tv)[32]) {
    const size_t o = (size_t)(pi.n0 + (lane & 31)) * D + pi.k0 + 32 * (lane >> 5);
    if (pi.f8) { unsigned w[8];
#pragma unroll
        for (int i = 0; i < 8; ++i) { int p0 = 0; p0 = __builtin_amdgcn_cvt_pk_fp8_f32(tv[4 * i], tv[4 * i + 1], p0, false); p0 = __builtin_amdgcn_cvt_pk_fp8_f32(tv[4 * i + 2], tv[4 * i + 3], p0, true); w[i] = (unsigned)p0; }
        u32x4* d = (u32x4*)(pi.dst + o); __builtin_nontemporal_store((u32x4){w[0], w[1], w[2], w[3]}, d); __builtin_nontemporal_store((u32x4){w[4], w[5], w[6], w[7]}, d + 1); }
    else { u32x4* d = (u32x4*)((bf16*)pi.dst + o);
#pragma unroll
        for (int i = 0; i < 4; ++i) d[i] = (u32x4){pk2(tv[8 * i], tv[8 * i + 1]), pk2(tv[8 * i + 2], tv[8 * i + 3]), pk2(tv[8 * i + 4], tv[8 * i + 5]), pk2(tv[8 * i + 6], tv[8 * i + 7])}; }
}

DEV void ph_h(const Params& P, int bid, int nb) {
    const int tid = phase_tid(), lane = tid & 63, wave = tid >> 6;
    const float* x = P.in[0]; const float* g1 = P.in[4]; const float* mod = (const float*)(P.ws + WS_MOD);
    bf16* h = (bf16*)(P.ws + WS_H);
    const int rbase = (bid & 7) * S + (bid >> 3) * 128 + wave * 16; const int ngw = 1;
    for (int row0 = rbase; row0 < rbase + 16; row0 += 2 * ngw) {
        f32x4 v[2][4]; int rows[2];
#pragma unroll
        for (int r = 0; r < 2; ++r) { rows[r] = row0 + r * ngw < T ? row0 + r * ngw : row0; const f32x4* xr = (const f32x4*)(x + (size_t)rows[r] * D) + lane;
#pragma unroll
            for (int j = 0; j < 4; ++j) v[r][j] = __builtin_nontemporal_load(&xr[64 * j]); }
#pragma unroll
        for (int r = 0; r < 2; ++r) {
            if (r > 0 && row0 + r * ngw >= T) break;
            const int row = rows[r], b = row >> 12; float ss = 0.f;
#pragma unroll
            for (int j = 0; j < 4; ++j) ss += (v[r][j].x * v[r][j].x + v[r][j].y * v[r][j].y) + (v[r][j].z * v[r][j].z + v[r][j].w * v[r][j].w);
            const float rstd = rsqrtf(wave_sum(ss) * (1.f / D) + EPS);
            const float* sh = mod + b * 6 * D; const float* scl = sh + D;
#pragma unroll
            for (int j = 0; j < 4; ++j) {
                const int k = 4 * lane + 256 * j;
                const f32x4 g = *(const f32x4*)(g1 + k), s1 = *(const f32x4*)(scl + k), s0 = *(const f32x4*)(sh + k);
                const float o0 = v[r][j].x * rstd * g.x * (1.f + s1.x) + s0.x, o1 = v[r][j].y * rstd * g.y * (1.f + s1.y) + s0.y;
                const float o2 = v[r][j].z * rstd * g.z * (1.f + s1.z) + s0.z, o3 = v[r][j].w * rstd * g.w * (1.f + s1.w) + s0.w;
                u32x2 o; o.x = pk2(o0, o1); o.y = pk2(o2, o3);
                *(u32x2*)(h + (size_t)row * D + k) = o;
            }
        }
    }
}

template <class ARow, class Epi>
DEV void wave_gemm64(const ARow& arow, const bf16* Bt, int K, int m0, int n0, const Epi& epi, int lane) {
    const int r = lane & 31, hh = lane >> 5;
    const bf16* a0 = arow(m0 + r) + 8 * hh; const bf16* a1 = arow(m0 + 32 + r) + 8 * hh;
    const bf16* b0 = Bt + (size_t)(n0 + r) * K + 8 * hh; const bf16* b1 = Bt + (size_t)(n0 + 32 + r) * K + 8 * hh;
    f32x16 c00 = {}, c01 = {}, c10 = {}, c11 = {};
    for (int k = 0; k < K; k += 16) {
        const bf16x8 fa0 = *(const bf16x8*)(a0 + k), fa1 = *(const bf16x8*)(a1 + k), fb0 = *(const bf16x8*)(b0 + k), fb1 = *(const bf16x8*)(b1 + k);
        c00 = __builtin_amdgcn_mfma_f32_32x32x16_bf16(fa0, fb0, c00, 0, 0, 0);
        c01 = __builtin_amdgcn_mfma_f32_32x32x16_bf16(fa0, fb1, c01, 0, 0, 0);
        c10 = __builtin_amdgcn_mfma_f32_32x32x16_bf16(fa1, fb0, c10, 0, 0, 0);
        c11 = __builtin_amdgcn_mfma_f32_32x32x16_bf16(fa1, fb1, c11, 0, 0, 0);
    }
#pragma unroll
    for (int g = 0; g < 16; ++g) {
        const int rr = (g & 3) + 8 * (g >> 2) + 4 * hh;
        epi(m0 + rr, n0 + r, c00[g]); epi(m0 + rr, n0 + 32 + r, c01[g]);
        epi(m0 + 32 + rr, n0 + r, c10[g]); epi(m0 + 32 + rr, n0 + 32 + r, c11[g]);
    }
}


namespace pg8 {
constexpr int BM = 256, BK = 64, HALF = 128, HTB = HALF * BK * 2, STAGE_BYTES = 8 * HTB, NXCD = 8, WGM = 4;
DEV int lds_byte(int r, int c) { const int st = (r >> 4) * 2 + (c >> 5), rr = r & 15, cc = c & 31, ob = rr * 64 + cc * 2; return st * 1024 + (ob ^ (((ob >> 9) & 1) << 5)); }
DEV void stage_rc(int b, int& R, int& C) { const int st = b / 1024, sb = b % 1024, swz = sb ^ (((sb >> 9) & 1) << 5); R = (st >> 1) * 16 + swz / 64; C = (st & 1) * 32 + (swz % 64) / 2; }
DEV int perm32(int rho) { const int n = rho >> 4, i = rho & 15; return 8 * (i >> 2) + 4 * n + (i & 3); }
struct Unit { int pm, pn, g; };
struct Ptrs { const char* a0; const char* a1; const char* b0; const char* b1; };
DEV unsigned cvt_pk_bf16(float lo, float hi) { unsigned r; asm volatile("v_cvt_pk_bf16_f32 %0, %1, %2" : "=v"(r) : "v"(lo), "v"(hi)); return r; }

struct StaticOrder {
    int nM, nN, nwg, G, c; const char* A; const char* Bt; int K;
    DEV void init(const bf16* A_, const bf16* Bt_, int M, int N, int K_, int G_, int c_) { nM = M / BM; nN = N / BM; nwg = nM * nN; G = G_; c = c_; A = (const char*)A_; Bt = (const char*)Bt_; K = K_; }
    DEV bool next(int i, Unit& u) const {
        const long L = (long)i * G + c; if (L >= nwg) return false;
        int wgid = (int)L; { const int q = nwg / NXCD, r = nwg % NXCD, xcd = wgid % NXCD, off = wgid / NXCD; wgid = (xcd < r ? xcd * (q + 1) : r * (q + 1) + (xcd - r) * q) + off; }
        const int nig = WGM * nN, gid = wgid / nig, fm = gid * WGM, gsz = (nM - fm) < WGM ? (nM - fm) : WGM;
        u.pm = fm + ((wgid % nig) % gsz); u.pn = (wgid % nig) / gsz; u.g = 0; return true;
    }
    DEV void ptrs(const Unit& u, Ptrs& p) const { const size_t hstep = (size_t)HALF * K * 2;
        p.a0 = A + (size_t)u.pm * 2 * hstep; p.a1 = p.a0 + hstep; p.b0 = Bt + (size_t)u.pn * 2 * hstep; p.b1 = p.b0 + hstep; }
    DEV int arow(const Unit&, int, int R) const { return R; }
};

typedef int v8i __attribute__((ext_vector_type(8)));
typedef int v4i __attribute__((ext_vector_type(4)));
template <class Epi, class Sched, bool ALIGN_EPI, bool GATHER, bool F8 = false>
DEV void gemm_phase(LAS unsigned char* lds, const int KB, const Sched& S, const Epi& E) {
    const int tid = phase_tid(), wid = __builtin_amdgcn_readfirstlane(tid >> 6), lane = tid & 63, wr = wid >> 2, wc = wid & 3, fr = lane & 15, fq = lane >> 4;
    const int nt = KB / (BK * 2);
    int sR[2], sC[2]; unsigned voffB[2];
#pragma unroll
    for (int i = 0; i < 2; ++i) { int R, C; stage_rc(tid * 16 + i * 8192, R, C); const int Rb = Epi::PERM ? ((R & ~31) + perm32(R & 31)) : R;
        sR[i] = R; sC[i] = C; voffB[i] = (unsigned)(Rb * KB + C * 2); }
    const size_t kstep = (size_t)(BK * 2);
    const unsigned ldsw = (unsigned)wid * 1024u;
    const int aoff = lds_byte(wr * 64 + fr, fq * 8), boff = lds_byte(wc * 32 + fr, fq * 8);
    const int a8o0 = lds_byte(wr * 64 + fr, (2 * (fq & 1)) * 8) + (fq >> 1) * 1024;
    const int b8o0 = lds_byte(wc * 32 + fr, (2 * (fq & 1)) * 8) + (fq >> 1) * 1024;
#define PG8_SA(b, h) (((b) * 2 + (h)) * HTB)
#define PG8_SB(b, h) ((4 + (b) * 2 + (h)) * HTB)
#define PG8_STAGE(bufoff, gbase, voff) do { const char* gb_ = (const char*)(gbase); asm volatile("" : "+s"(gb_)); _Pragma("unroll") for (int _i = 0; _i < 2; ++_i) { \
        unsigned vo_ = (voff)[_i]; asm volatile("" : "+v"(vo_)); \
        __builtin_amdgcn_global_load_lds((const unsigned*)(gb_ + vo_), (LAS unsigned*)(lds + (bufoff) + ldsw + _i * 8192), 16, 0, 0); } } while (0)
    LAS unsigned char* abase = lds + (F8 ? a8o0 : aoff); LAS unsigned char* bbase = lds + 4 * HTB + (F8 ? b8o0 : boff);
    asm volatile("" : "+v"(abase), "+v"(bbase));
#define PG8_LDA(dst, b, h) do { _Pragma("unroll") for (int m = 0; m < 4; ++m) { _Pragma("unroll") for (int k = 0; k < 2; ++k) dst[m][k] = *(const LAS bf16x8*)(abase + ((b) * 2 + (h)) * HTB + m * 2048 + k * (F8 ? 16 : 1024)); } } while (0)
#define PG8_LDB(dst, b, h) do { _Pragma("unroll") for (int n = 0; n < 2; ++n) { _Pragma("unroll") for (int k = 0; k < 2; ++k) dst[n][k] = *(const LAS bf16x8*)(bbase + ((b) * 2 + (h)) * HTB + n * 2048 + k * (F8 ? 16 : 1024)); } } while (0)
#define PG8_F8V(lo, hi) __builtin_shufflevector(__builtin_bit_cast(v4i, lo), __builtin_bit_cast(v4i, hi), 0, 1, 2, 3, 4, 5, 6, 7)
#define PG8_MMA(ai, bj, At, Bt) do { __builtin_amdgcn_s_setprio(1); _Pragma("unroll") for (int m = 0; m < 4; ++m) _Pragma("unroll") for (int n = 0; n < 2; ++n) { \
        if (F8) { acc[ai][bj][m][n] = __builtin_amdgcn_mfma_scale_f32_16x16x128_f8f6f4(PG8_F8V(Bt[n][0], Bt[n][1]), PG8_F8V(At[m][0], At[m][1]), acc[ai][bj][m][n], 0, 0, 0, 0x7F7F7F7F, 0, 0x7F7F7F7F); } \
        else { _Pragma("unroll") for (int k = 0; k < 2; ++k) acc[ai][bj][m][n] = __builtin_amdgcn_mfma_f32_16x16x32_bf16(Bt[n][k], At[m][k], acc[ai][bj][m][n], 0, 0, 0); } } \
        if (F8) asm volatile("" :: "v"(acc[ai][bj][0][0]), "v"(acc[ai][bj][0][1]), "v"(acc[ai][bj][1][0]), "v"(acc[ai][bj][1][1]), "v"(acc[ai][bj][2][0]), "v"(acc[ai][bj][2][1]), "v"(acc[ai][bj][3][0]), "v"(acc[ai][bj][3][1]));   \
        __builtin_amdgcn_s_setprio(0); } while (0)
#define PG8_WAIT_V(n) asm volatile("s_waitcnt vmcnt(" #n ")" ::: "memory")
#define PG8_WAIT_L(n) asm volatile("s_waitcnt lgkmcnt(" #n ")" ::: "memory")
#define PG8_BAR __builtin_amdgcn_s_barrier()
#define PG8_SCHED __builtin_amdgcn_sched_barrier(0)
    Unit cur, nxt; int ui = 0;
    if (!S.next(0, cur)) return;
    f32x4 acc[2][2][4][2];
#pragma unroll
    for (int a = 0; a < 2; ++a)
#pragma unroll
        for (int b = 0; b < 2; ++b)
#pragma unroll
            for (int m = 0; m < 4; ++m)
#pragma unroll
                for (int n = 0; n < 2; ++n) acc[a][b][m][n] = (f32x4){0.f, 0.f, 0.f, 0.f};
    bf16x8 At[4][2], B0[2][2], B1[2][2];
    Ptrs cp; S.ptrs(cur, cp);
    unsigned vA0[2], vA1[2];
#pragma unroll
    for (int i = 0; i < 2; ++i) { vA0[i] = (unsigned)(S.arow(cur, 0, sR[i]) * KB + sC[i] * 2); vA1[i] = GATHER ? (unsigned)(S.arow(cur, 1, sR[i]) * KB + sC[i] * 2) : vA0[i]; }
    PG8_STAGE(PG8_SB(0, 0), cp.b0, voffB); PG8_STAGE(PG8_SB(0, 1), cp.b1, voffB); PG8_STAGE(PG8_SA(0, 0), cp.a0, vA0); PG8_STAGE(PG8_SA(0, 1), cp.a1, vA1);
    if (wr == 1) PG8_BAR;
    PG8_WAIT_V(2); PG8_BAR;
    PG8_STAGE(PG8_SB(1, 0), cp.b0 + kstep, voffB); PG8_STAGE(PG8_SA(1, 0), cp.a0 + kstep, vA0); PG8_STAGE(PG8_SB(1, 1), cp.b1 + kstep, voffB);
    PG8_WAIT_V(6); PG8_BAR;
    for (;;) {
        const bool has_next = S.next(ui + 1, nxt);
        Ptrs np = cp;
        if (has_next) S.ptrs(nxt, np);
        for (int t = 0; t < nt; t += 2) {
            const bool last = (t == nt - 2);
            const char* a1h1 = cp.a1 + (size_t)(t + 1) * kstep;
            const char* a2h0 = last ? np.a0 : cp.a0 + (size_t)(t + 2) * kstep; const char* a2h1 = last ? np.a1 : cp.a1 + (size_t)(t + 2) * kstep;
            const char* b2h0 = last ? np.b0 : cp.b0 + (size_t)(t + 2) * kstep; const char* b2h1 = last ? np.b1 : cp.b1 + (size_t)(t + 2) * kstep;
            PG8_LDB(B0, 0, 0); PG8_LDB(B1, 0, 1); PG8_SCHED; PG8_LDA(At, 0, 0); PG8_STAGE(PG8_SA(1, 1), a1h1, vA1);
            PG8_WAIT_V(8); PG8_WAIT_L(0); PG8_BAR; PG8_MMA(0, 0, At, B0); PG8_MMA(0, 1, At, B1); PG8_BAR; PG8_SCHED;
            PG8_LDA(At, 0, 1); PG8_STAGE(PG8_SB(0, 0), b2h0, voffB); PG8_STAGE(PG8_SB(0, 1), b2h1, voffB); PG8_STAGE(PG8_SA(0, 0), a2h0, vA0);
            PG8_WAIT_V(8); PG8_WAIT_L(0); PG8_BAR; PG8_MMA(1, 0, At, B0); PG8_MMA(1, 1, At, B1); PG8_BAR; PG8_SCHED;
            PG8_LDB(B0, 1, 0); PG8_LDB(B1, 1, 1); PG8_SCHED; PG8_LDA(At, 1, 0); PG8_STAGE(PG8_SA(0, 1), a2h1, vA1);
            PG8_WAIT_V(8); PG8_WAIT_L(0); PG8_BAR; PG8_MMA(0, 0, At, B0); PG8_MMA(0, 1, At, B1); PG8_BAR; PG8_SCHED;
            PG8_LDA(At, 1, 1); PG8_STAGE(PG8_SB(1, 0), b2h0 + kstep, voffB); PG8_STAGE(PG8_SB(1, 1), b2h1 + kstep, voffB); PG8_STAGE(PG8_SA(1, 0), a2h0 + kstep, vA0);
            PG8_WAIT_V(8); PG8_WAIT_L(0); PG8_BAR; PG8_MMA(1, 0, At, B0); PG8_MMA(1, 1, At, B1); PG8_BAR; PG8_SCHED;
        }
        if constexpr (ALIGN_EPI) { if (wr == 0) PG8_BAR; }
        E(acc, cur, wr, wc, fr, fq);
        if (!has_next) break;
#pragma unroll
        for (int a = 0; a < 2; ++a)
#pragma unroll
            for (int b = 0; b < 2; ++b)
#pragma unroll
                for (int m = 0; m < 4; ++m)
#pragma unroll
                    for (int n = 0; n < 2; ++n) acc[a][b][m][n] = (f32x4){0.f, 0.f, 0.f, 0.f};
        cur = nxt; cp = np; ++ui;
        if constexpr (ALIGN_EPI) { if (wr == 1) PG8_BAR; }
    }
    PG8_WAIT_V(0);
    if constexpr (!ALIGN_EPI) { if (wr == 0) PG8_BAR; }
    PG8_BAR;
#undef PG8_SA
#undef PG8_SB
#undef PG8_STAGE
#undef PG8_LDA
#undef PG8_LDB
#undef PG8_MMA
#undef PG8_F8V
#undef PG8_WAIT_V
#undef PG8_WAIT_L
#undef PG8_BAR
#undef PG8_SCHED
}

struct EpiBf16 {
    static constexpr bool PERM = true;
    bf16* O; int ldc;
    DEV void operator()(const f32x4 (&acc)[2][2][4][2], const Unit& u, int wr, int wc, int fr, int fq) const {
        const int row0 = u.pm * BM + wr * 64 + fr, col0 = u.pn * BM + wc * 32 + 8 * fq;
#pragma unroll
        for (int ai = 0; ai < 2; ++ai)
#pragma unroll
            for (int m = 0; m < 4; ++m) { bf16* rowp = O + (size_t)(row0 + ai * HALF + m * 16) * ldc + col0;
#pragma unroll
                for (int bj = 0; bj < 2; ++bj) { const f32x4 v0 = acc[ai][bj][m][0], v1 = acc[ai][bj][m][1];
                    u32x4 w; w.x = cvt_pk_bf16(v0[0], v0[1]); w.y = cvt_pk_bf16(v0[2], v0[3]); w.z = cvt_pk_bf16(v1[0], v1[1]); w.w = cvt_pk_bf16(v1[2], v1[3]);
                    *(u32x4*)(rowp + bj * HALF) = w; } }
    }
};
struct EpiInProj {
    static constexpr bool PERM = true;
    bf16* O; const float* gq; const float* gk; LAS float* xch; unsigned char* QK8;
    DEV void operator()(const f32x4 (&acc)[2][2][4][2], const Unit& u, int wr, int wc, int fr, int fq) const {
        const int row0 = u.pm * BM + wr * 64 + fr, col0 = u.pn * BM + wc * 32 + 8 * fq;
        const bool isqk = (u.pn >= 4) && (u.pn < 8);
        float rs[2][4][2];
        float gs[8];
        if (isqk) {
            const bool isq = u.pn < 6; const float* g = (isq ? gq : gk) + (wc & 1) * 32 + 8 * fq; const float sc = isq ? 0.125f * 1.4426950408889634f : 1.f;
#pragma unroll
            for (int i = 0; i < 8; ++i) gs[i] = g[i] * sc;
            const int wid = wr * 4 + wc;
#pragma unroll
            for (int ai = 0; ai < 2; ++ai)
#pragma unroll
                for (int m = 0; m < 4; ++m)
#pragma unroll
                    for (int bj = 0; bj < 2; ++bj) { const f32x4 v0 = acc[ai][bj][m][0], v1 = acc[ai][bj][m][1];
                        float s = (v0[0] * v0[0] + v0[1] * v0[1]) + (v0[2] * v0[2] + v0[3] * v0[3]) + (v1[0] * v1[0] + v1[1] * v1[1]) + (v1[2] * v1[2] + v1[3] * v1[3]);
                        s += __shfl_xor(s, 16); s += __shfl_xor(s, 32);
                        rs[ai][m][bj] = s;
                        if (fq == 0) xch[(wid * 16 + (ai * 4 + m) * 2 + bj) * 16 + fr] = s; }
            asm volatile("s_waitcnt lgkmcnt(0)" ::: "memory"); __builtin_amdgcn_s_barrier(); asm volatile("" ::: "memory");
            const int pw = wr * 4 + (wc ^ 1);
#pragma unroll
            for (int ai = 0; ai < 2; ++ai)
#pragma unroll
                for (int m = 0; m < 4; ++m)
#pragma unroll
                    for (int bj = 0; bj < 2; ++bj) { const float tot = rs[ai][m][bj] + xch[(pw * 16 + (ai * 4 + m) * 2 + bj) * 16 + fr];
                        rs[ai][m][bj] = rsqrtf(tot * (1.f / 64.f) + EPS); }
        }
#pragma unroll
        for (int ai = 0; ai < 2; ++ai)
#pragma unroll
            for (int m = 0; m < 4; ++m) { bf16* rowp = O + (size_t)(row0 + ai * HALF + m * 16) * NPROJ + col0;
#pragma unroll
                for (int bj = 0; bj < 2; ++bj) { f32x4 v0 = acc[ai][bj][m][0], v1 = acc[ai][bj][m][1];
                    if (isqk) { const float r = rs[ai][m][bj];
                        v0[0] *= r * gs[0]; v0[1] *= r * gs[1]; v0[2] *= r * gs[2]; v0[3] *= r * gs[3]; v1[0] *= r * gs[4]; v1[1] *= r * gs[5]; v1[2] *= r * gs[6]; v1[3] *= r * gs[7];
                        u32x2 w8; w8.x = pk4_fp8(v0[0], v0[1], v0[2], v0[3]); w8.y = pk4_fp8(v1[0], v1[1], v1[2], v1[3]);
                        *(u32x2*)(QK8 + (size_t)(row0 + ai * HALF + m * 16) * 1024 + (u.pn - 4) * BM + bj * HALF + wc * 32 + 8 * fq) = w8; }
                    else { u32x4 w; w.x = cvt_pk_bf16(v0[0], v0[1]); w.y = cvt_pk_bf16(v0[2], v0[3]); w.z = cvt_pk_bf16(v1[0], v1[1]); w.w = cvt_pk_bf16(v1[2], v1[3]);
                        *(u32x4*)(rowp + bj * HALF) = w; } } }
    }
};
struct EpiResGate {
    static constexpr bool PERM = true;
    const float* x; bf16* x1; int ld; const float* mod;
    DEV void operator()(const f32x4 (&acc)[2][2][4][2], const Unit& u, int wr, int wc, int fr, int fq) const {
        const int row0 = u.pm * BM + wr * 64 + fr, col0 = u.pn * BM + wc * 32 + 8 * fq;
        const int b = (u.pm * BM) >> 12;
        f32x4 gv[2][2];
#pragma unroll
        for (int bj = 0; bj < 2; ++bj)
#pragma unroll
            for (int n = 0; n < 2; ++n) gv[bj][n] = *(const f32x4*)(mod + b * 6 * D + 2 * D + col0 + bj * HALF + n * 4);
#pragma unroll
        for (int ai = 0; ai < 2; ++ai)
#pragma unroll
            for (int m = 0; m < 4; ++m) { const int row = row0 + ai * HALF + m * 16;
#pragma unroll
                for (int bj = 0; bj < 2; ++bj) { const float* xp = x + (size_t)row * D + col0 + bj * HALF;
                    const f32x4 v0 = __builtin_nontemporal_load((const f32x4*)xp) + gv[bj][0] * acc[ai][bj][m][0], v1 = __builtin_nontemporal_load((const f32x4*)(xp + 4)) + gv[bj][1] * acc[ai][bj][m][1];
                    u32x4 w; w.x = cvt_pk_bf16(v0[0], v0[1]); w.y = cvt_pk_bf16(v0[2], v0[3]); w.z = cvt_pk_bf16(v1[0], v1[1]); w.w = cvt_pk_bf16(v1[2], v1[3]);
                    *(u32x4*)(x1 + (size_t)row * ld + col0 + bj * HALF) = w; }
                if (m == 3) asm volatile("" ::: "memory"); }
    }
};
}


namespace pg8 {
struct MoeUpOrder {
    int e, b, pm, g; const char* h2; const char* w1; const char* w3; const LAS int* rowtab;
    DEV bool next(int i, Unit& u) const { if (i >= 8) return false; u.pm = pm; u.pn = i; u.g = g; return true; }
    DEV void ptrs(const Unit& u, Ptrs& p) const { p.a0 = h2 + (size_t)b * S * D; p.a1 = p.a0;
        const size_t off = ((size_t)e * D + (size_t)u.pn * HALF) * D; p.b0 = w1 + off; p.b1 = w3 + off; }
    DEV int arow(const Unit&, int half, int R) const { return rowtab[half * HALF + R]; }
};
struct EpiSwiGLU {
    static constexpr bool PERM = true;
    unsigned char* H; const LAS float* gval;
    DEV void operator()(const f32x4 (&acc)[2][2][4][2], const Unit& u, int wr, int wc, int fr, int fq) const {
        { const int t2_ = phase_tid(); fr = t2_ & 15; fq = (t2_ & 63) >> 4; }
        const int row0 = u.g * CAP + u.pm * BM + wr * 64 + fr, col0 = u.pn * HALF + wc * 32 + 8 * fq;
#pragma unroll
        for (int ai = 0; ai < 2; ++ai)
#pragma unroll
            for (int m = 0; m < 4; ++m) { const int row = row0 + ai * HALF + m * 16; unsigned char* rowp = H + (size_t)row * D + col0; const float gs = gval[wr * 64 + fr + ai * HALF + m * 16] * 4.f;
                float o[8];
#pragma unroll
                for (int n = 0; n < 2; ++n)
#pragma unroll
                    for (int j = 0; j < 4; ++j) { const float a = acc[ai][0][m][n][j], bb = acc[ai][1][m][n][j]; o[n * 4 + j] = (a * gs) * __builtin_amdgcn_rcpf(1.f + __builtin_amdgcn_exp2f(a * -1.4426950408889634f)) * bb; }
                u32x2 w; w.x = pk4_fp8(o[0], o[1], o[2], o[3]); w.y = pk4_fp8(o[4], o[5], o[6], o[7]);
                *(u32x2*)rowp = w; }
    }
};
struct MoeDownOrder {
    int e, pm, g; const char* hb; const char* w2;
    DEV bool next(int i, Unit& u) const { if (i >= 4) return false; u.pm = pm; u.pn = i; u.g = g; return true; }
    DEV void ptrs(const Unit& u, Ptrs& p) const { const size_t hstep = (size_t)HALF * D;
        p.a0 = hb + ((size_t)g * CAP + (size_t)pm * BM) * D; p.a1 = p.a0 + hstep; p.b0 = w2 + ((size_t)e * D + (size_t)u.pn * BM) * D; p.b1 = p.b0 + hstep; }
    DEV int arow(const Unit&, int, int R) const { return R; }
};
struct EpiScaleRow {
    static constexpr bool PERM = true;
    unsigned char* Y;
    DEV void operator()(const f32x4 (&acc)[2][2][4][2], const Unit& u, int wr, int wc, int fr, int fq) const {
        { const int t2_ = phase_tid(); fr = t2_ & 15; fq = (t2_ & 63) >> 4; }
        const int row0 = u.g * CAP + u.pm * BM + wr * 64 + fr, col0 = u.pn * BM + wc * 32 + 8 * fq;
#pragma unroll
        for (int ai = 0; ai < 2; ++ai)
#pragma unroll
            for (int m = 0; m < 4; ++m) { unsigned char* rowp = Y + (size_t)(row0 + ai * HALF + m * 16) * D + col0;
#pragma unroll
                for (int bj = 0; bj < 2; ++bj) { const f32x4 v0 = acc[ai][bj][m][0] * 8.f, v1 = acc[ai][bj][m][1] * 8.f;
                    u32x2 w; w.x = pk4_fp8(v0[0], v0[1], v0[2], v0[3]); w.y = pk4_fp8(v1[0], v1[1], v1[2], v1[3]);
                    *(u32x2*)(rowp + bj * HALF) = w; } }
    }
};
}

DEV void ph_inproj(const Params& P, int bid, int nb, unsigned char* lds) {
    pg8::StaticOrder S; S.init((const bf16*)(P.ws + WS_H), (const bf16*)(P.ws + WS_WIN), T, NPROJ, D, nb, bid);
    pg8::EpiInProj E{(bf16*)(P.ws + WS_PROJ), P.in[13], P.in[14], (LAS float*)((LAS unsigned char*)lds + LDS_MISC + 2048), P.ws + WS_QK8};
    pg8::gemm_phase<pg8::EpiInProj, pg8::StaticOrder, true, false>((LAS unsigned char*)lds, D * 2, S, E);
}

DEV void ph_qknorm_conv(const Params& P, int bid, int nb, bool probe = false) {
    const int tid = phase_tid(), lane = tid & 63, wave = tid >> 6;
    bf16* proj = (bf16*)(P.ws + WS_PROJ);
    const float* gq = P.in[13]; const float* gk = P.in[14];
    const int grp = lane >> 2, part = lane & 3;
    const bool isq = grp < 8; const float sc = isq ? 0.125f * 1.4426950408889634f : 1.f;
    float gsc[16];
#pragma unroll
    for (int i = 0; i < 16; ++i) gsc[i] = (isq ? gq : gk)[part * 16 + i] * sc;
    const int gw = bid * NWAVE + wave, ngw = nb * NWAVE;
    for (int row0 = gw; row0 < T; row0 += 4 * ngw) {
        u32x4 w[4][2]; bf16* p[4];
#pragma unroll
        for (int r = 0; r < 4; ++r) { const int row = row0 + r * ngw < T ? row0 + r * ngw : row0; p[r] = proj + (size_t)row * NPROJ + 1024 + grp * 64 + part * 16;
            w[r][0] = *(const u32x4*)p[r]; w[r][1] = *(const u32x4*)(p[r] + 8); }
#pragma unroll
        for (int r = 0; r < 4; ++r) {
            if (r > 0 && row0 + r * ngw >= T) break;
            const unsigned ww[8] = {w[r][0].x, w[r][0].y, w[r][0].z, w[r][0].w, w[r][1].x, w[r][1].y, w[r][1].z, w[r][1].w};
            float v[16]; float ss = 0.f;
#pragma unroll
            for (int i = 0; i < 8; ++i) { v[2 * i] = __uint_as_float(ww[i] << 16); v[2 * i + 1] = __uint_as_float(ww[i] & 0xffff0000u); }
#pragma unroll
            for (int i = 0; i < 16; ++i) ss += v[i] * v[i];
            ss += __shfl_xor(ss, 1); ss += __shfl_xor(ss, 2);
            const float rstd = rsqrtf(ss * (1.f / 64.f) + EPS);
            unsigned o[8];
#pragma unroll
            for (int i = 0; i < 8; ++i) o[i] = pk2(v[2 * i] * rstd * gsc[2 * i], v[2 * i + 1] * rstd * gsc[2 * i + 1]);
            bf16* po = probe ? (bf16*)(P.ws + WS_H) + (p[r] - proj) % (32u << 20) : p[r];
            *(u32x4*)po = (u32x4){o[0], o[1], o[2], o[3]}; *(u32x4*)(po + 8) = (u32x4){o[4], o[5], o[6], o[7]};
        }
    }
}

namespace lru {
typedef float f32x4v __attribute__((ext_vector_type(4)));
constexpr int SUB = 64, SPAN = 1024, NSUB = SPAN / SUB, NSPAN = S / SPAN;
constexpr int G_XL = 0;
constexpr int G_XC = 8704;
constexpr int G_XCB = G_XC + 16384;
constexpr int G_SEG = G_XCB + 64 * 72 * 2;
constexpr int G_CIN = G_SEG + 8192;
constexpr int G_CAR = G_CIN + 4096;
constexpr int G_CW = G_CAR + 512;
constexpr int G_BYTES = G_CW + 1280;
static_assert(2 * G_BYTES <= 131072, "LRU LDS");
static_assert(4096 * 4 + 9 * XCD_BAR_WORDS * 4 <= 144 * 1024, "control words (grid barrier + 8 group barriers) inside the per-call memset");
DEV float gelu_tanh_fast(float x) { const float u = 0.7978845608028654f * (x + 0.044715f * x * x * x); const float e = __expf(2.f * u); return x * (1.f - __builtin_amdgcn_rcpf(e + 1.f)); }

template <int MODE>
DEV void sweep2(const Params& P, unsigned char* lds0, int b, int n, int span, int bid, int nb) {
    const int tid = phase_tid(), lane = tid & 63, wid = __builtin_amdgcn_readfirstlane(tid >> 6);
    const int dir = wid >> 2, lw = wid & 3, lt = tid & 255;
    unsigned char* lds = lds0 + dir * G_BYTES;
    const bf16* proj = (const bf16*)(P.ws + WS_PROJ); bf16* ycat = (bf16*)(P.ws + WS_YCAT);
    float* sum = (float*)(P.ws + WS_LSUM);
    bf16* XL = (bf16*)(lds + G_XL); float* XC = (float*)(lds + G_XC); bf16* XCB = (bf16*)(lds + G_XCB);
    float* SEG = (float*)(lds + G_SEG); float* CIN = (float*)(lds + G_CIN); float* CAR = (float*)(lds + G_CAR); float* CW = (float*)(lds + G_CW);
    const int ch0 = n * 64;
    const int db = lw, fr = lane & 15, fq = lane >> 4;
    bf16x8 Ba[2], Bx[2];
    { const float* wa = P.in[8] + ((size_t)(dir * 8 + n) * 64) * 64 + db * 16 + fr; const float* wx = P.in[10] + ((size_t)(dir * 8 + n) * 64) * 64 + db * 16 + fr;
#pragma unroll
      for (int ks = 0; ks < 2; ++ks) { unsigned pa[4], px[4];
#pragma unroll
          for (int jj = 0; jj < 4; ++jj) { const int c = ks * 32 + fq * 8 + 2 * jj; pa[jj] = pk2(wa[c * 64], wa[(c + 1) * 64]); px[jj] = pk2(wx[c * 64], wx[(c + 1) * 64]); }
          const u32x4 va = {pa[0], pa[1], pa[2], pa[3]}, vx = {px[0], px[1], px[2], px[3]};
          Ba[ks] = *reinterpret_cast<const bf16x8*>(&va); Bx[ks] = *reinterpret_cast<const bf16x8*>(&vx); } }
    const int cl = db * 16 + fr;
    const int gch = dir * DL + ch0 + cl;
    const float ba = P.in[9][gch], bx = P.in[11][gch];
    float ls; { const float l = P.in[12][gch]; ls = 8.0f * (fminf(l, 0.f) - log1pf(__expf(-fabsf(l)))); }
    const float ls2 = ls * 1.4426950408889634f, nba = -ba * 1.4426950408889634f, nbx = -bx * 1.4426950408889634f;
    __syncthreads();
    CW[lt] = P.in[6][(lt >> 6) * DL + ch0 + (lt & 63)];
    if (lt < 64) {
        CW[256 + lt] = P.in[7][ch0 + lt];
        if (MODE == 1) { float h = 0.f; const float* sp = sum + ((size_t)(b * 2 + dir) * NSPAN) * DL * 2 + (size_t)(ch0 + lt) * 2;
            float2 m4[NSPAN];
#pragma unroll
            for (int s2 = 0; s2 < NSPAN; ++s2) m4[s2] = *(const float2*)(sp + (size_t)s2 * DL * 2);
            if (dir == 0) {
#pragma unroll
                for (int s2 = 0; s2 < NSPAN; ++s2) h = s2 < span ? m4[s2].x * h + m4[s2].y : h;
            } else {
#pragma unroll
                for (int s2 = NSPAN - 1; s2 >= 0; --s2) h = s2 > span ? m4[s2].x * h + m4[s2].y : h;
            }
            CAR[2 * lt + 1] = h; }
    }
    u32x4 xp[3];
    bf16* xcg = (bf16*)(P.ws + WS_XCG);
#define XL_LOAD(kx) do { const int t0_ = span * SPAN + (kx) * SUB; \
        if (MODE == 0) { _Pragma("unroll") for (int q_ = 0; q_ < 3; ++q_) { const int p_ = q_ * 256 + lt; xp[q_] = (u32x4){0u, 0u, 0u, 0u}; \
            if (p_ < 67 * 8) { const int t = t0_ - 2 + (p_ >> 3); if (t >= 0 && t < S) xp[q_] = *(const u32x4*)(proj + ((size_t)b * S + t) * NPROJ + ch0 + (p_ & 7) * 8); } } } \
        else { _Pragma("unroll") for (int q_ = 0; q_ < 2; ++q_) { const int p_ = q_ * 256 + lt; xp[q_] = *(const u32x4*)(xcg + ((size_t)b * S + t0_ + (p_ >> 3)) * DL + ch0 + (p_ & 7) * 8); } } } while (0)
    XL_LOAD(dir == 0 ? 0 : NSUB - 1);
    const int pgw = bid * NWAVE + wid, pngw = nb * NWAVE;
    float Ar = 1.f, Hr = 0.f, hrun = 0.f;
    for (int kk = 0; kk < NSUB; ++kk) {
        const int k = dir == 0 ? kk : NSUB - 1 - kk;
        const int t0 = span * SPAN + k * SUB;
        const size_t row0 = (size_t)b * S + t0;
        Prep2Item pit; float ptv[32]; bool phas = false;
        if (MODE == 0) { phas = prep2_decode(P, PREP2_IOUT + pgw + kk * pngw, pit); if (phas) prep2_load(pit, lane, ptv); }
        if (MODE == 0) {
#pragma unroll
            for (int q = 0; q < 3; ++q) { const int p = q * 256 + lt; if (p < 67 * 8) *(u32x4*)(XL + (p >> 3) * 64 + (p & 7) * 8) = xp[q]; }
        } else {
#pragma unroll
            for (int q = 0; q < 2; ++q) { const int p = q * 256 + lt; *(u32x4*)(XCB + (p >> 3) * 72 + (p & 7) * 8) = xp[q]; }
        }
        if (kk + 1 < NSUB) XL_LOAD(dir == 0 ? kk + 1 : NSUB - 2 - kk);
        __syncthreads();
        const bool second = (MODE == 1) && (kk >= NSUB / 2);
        u32x4 pk_h[2], pk_z[2];
        if (second) { const int t = lt >> 2, c16 = (lt & 3) * 16;
            pk_h[0] = *(const u32x4*)(ycat + (row0 + t) * D + ch0 + c16); pk_h[1] = *(const u32x4*)(ycat + (row0 + t) * D + ch0 + c16 + 8);
            pk_z[0] = *(const u32x4*)(proj + (row0 + t) * NPROJ + 512 + ch0 + c16); pk_z[1] = *(const u32x4*)(proj + (row0 + t) * NPROJ + 512 + ch0 + c16 + 8); }
        if (MODE == 0) {
        { const int t = lt >> 2, c16 = (lt & 3) * 16; float acc[16];
#pragma unroll
          for (int i = 0; i < 16; i += 4) { const f32x4v cb4 = *(const f32x4v*)(CW + 256 + c16 + i); acc[i] = cb4.x; acc[i + 1] = cb4.y; acc[i + 2] = cb4.z; acc[i + 3] = cb4.w; }
#pragma unroll
          for (int w = 0; w < 4; ++w) {
#pragma unroll
              for (int hlf = 0; hlf < 2; ++hlf) { const u32x4 xv = *(const u32x4*)(XL + (t + w) * 64 + c16 + hlf * 8); const unsigned xw[4] = {xv.x, xv.y, xv.z, xv.w};
                  const f32x4v w0 = *(const f32x4v*)(CW + w * 64 + c16 + hlf * 8), w1 = *(const f32x4v*)(CW + w * 64 + c16 + hlf * 8 + 4);
                  const float wv[8] = {w0.x, w0.y, w0.z, w0.w, w1.x, w1.y, w1.z, w1.w};
#pragma unroll
                  for (int i = 0; i < 4; ++i) { acc[hlf * 8 + 2 * i] += wv[2 * i] * __uint_as_float(xw[i] << 16); acc[hlf * 8 + 2 * i + 1] += wv[2 * i + 1] * __uint_as_float(xw[i] & 0xffff0000u); } } }
          const u32x4 o0 = {pk2(acc[0], acc[1]), pk2(acc[2], acc[3]), pk2(acc[4], acc[5]), pk2(acc[6], acc[7])}, o1 = {pk2(acc[8], acc[9]), pk2(acc[10], acc[11]), pk2(acc[12], acc[13]), pk2(acc[14], acc[15])};
          *(u32x4*)(XCB + t * 72 + c16) = o0; *(u32x4*)(XCB + t * 72 + c16 + 8) = o1;
          if (dir == (k < NSUB / 2 ? 0 : 1)) { bf16* gp = xcg + (row0 + t) * DL + ch0 + c16; *(u32x4*)gp = o0; *(u32x4*)(gp + 8) = o1; } }
        __syncthreads();
        }
        if (MODE == 1 && kk == 0) hrun = CAR[2 * cl + 1];
        float av[16], uv[16], EA[4], EH[4], TA[4], TH[4];
        const bool first = (dir == 0) ? !(fq & 1) : (fq & 1), firstpair = (dir == 0) ? !(fq & 2) : ((fq & 2) != 0);
#pragma unroll
        for (int tb = 0; tb < 4; ++tb) {
            f32x4v ga = {0.f, 0.f, 0.f, 0.f}, gx = {0.f, 0.f, 0.f, 0.f};
#pragma unroll
            for (int ks = 0; ks < 2; ++ks) { const bf16x8 af = *(const bf16x8*)(XCB + (tb * 16 + fr) * 72 + ks * 32 + fq * 8);
                ga = __builtin_amdgcn_mfma_f32_16x16x32_bf16(af, Ba[ks], ga, 0, 0, 0); gx = __builtin_amdgcn_mfma_f32_16x16x32_bf16(af, Bx[ks], gx, 0, 0, 0); }
#pragma unroll
            for (int rg = 0; rg < 4; ++rg) { const int t = tb * 16 + fq * 4 + rg;
                const float r = __builtin_amdgcn_rcpf(1.f + __builtin_amdgcn_exp2f(__builtin_fmaf(ga[rg], -1.4426950408889634f, nba)));
                const float ig = __builtin_amdgcn_rcpf(1.f + __builtin_amdgcn_exp2f(__builtin_fmaf(gx[rg], -1.4426950408889634f, nbx)));
                const float a = __builtin_amdgcn_exp2f(r * ls2); av[tb * 4 + rg] = a;
                uv[tb * 4 + rg] = __builtin_amdgcn_sqrtf(fmaxf(__builtin_fmaf(-a, a, 1.f), 0.f)) * (ig * bf2f(XCB[t * 72 + cl])); }
            float A = 1.f, H = 0.f;
            if (dir == 0) {
#pragma unroll
                for (int i = 0; i < 4; ++i) { H = av[tb * 4 + i] * H + uv[tb * 4 + i]; A *= av[tb * 4 + i]; }
            } else {
#pragma unroll
                for (int i = 3; i >= 0; --i) { H = av[tb * 4 + i] * H + uv[tb * 4 + i]; A *= av[tb * 4 + i]; }
            }
            const float oA = __shfl_xor(A, 16), oH = __shfl_xor(H, 16);
            const float PA = A * oA, PH = first ? (oA * H + oH) : (A * oH + H);
            const float QA = __shfl_xor(PA, 32), QH = __shfl_xor(PH, 32);
            TA[tb] = PA * QA; TH[tb] = firstpair ? (QA * PH + QH) : (PA * QH + PH);
            const float XA = first ? 1.f : oA, XH = first ? 0.f : oH, YA = firstpair ? 1.f : QA, YH = firstpair ? 0.f : QH;
            EA[tb] = XA * YA; EH[tb] = XA * YH + XH;
        }
        if (MODE == 0) {
            if (dir == 0) {
#pragma unroll
                for (int tb = 0; tb < 4; ++tb) { Hr = TA[tb] * Hr + TH[tb]; Ar *= TA[tb]; }
            } else {
#pragma unroll
                for (int tb = 3; tb >= 0; --tb) { Hr = TA[tb] * Hr + TH[tb]; Ar *= TA[tb]; }
            }
        }
        if (MODE == 0) { if (phas) prep2_finish(pit, lane, ptv); }
        if (MODE == 1) {
            if (dir == 0) {
#pragma unroll
                for (int tb = 0; tb < 4; ++tb) { float h = EA[tb] * hrun + EH[tb]; hrun = TA[tb] * hrun + TH[tb]; float hv[4];
#pragma unroll
                    for (int i = 0; i < 4; ++i) { h = av[tb * 4 + i] * h + uv[tb * 4 + i]; hv[i] = h; }
#pragma unroll
                    for (int rg = 0; rg < 4; ++rg) XC[(tb * 16 + fq * 4 + rg) * 64 + cl] = hv[rg]; }
            } else {
#pragma unroll
                for (int tb = 3; tb >= 0; --tb) { float h = EA[tb] * hrun + EH[tb]; hrun = TA[tb] * hrun + TH[tb]; float hv[4];
#pragma unroll
                    for (int i = 3; i >= 0; --i) { h = av[tb * 4 + i] * h + uv[tb * 4 + i]; hv[i] = h; }
#pragma unroll
                    for (int rg = 0; rg < 4; ++rg) XC[(tb * 16 + fq * 4 + rg) * 64 + cl] = hv[rg]; }
            }
            __syncthreads();
            { const int t = lt >> 2, c16 = (lt & 3) * 16; float hh[16];
#pragma unroll
              for (int i = 0; i < 16; i += 4) { const f32x4v v4 = *(const f32x4v*)(XC + t * 64 + c16 + i); hh[i] = v4.x; hh[i + 1] = v4.y; hh[i + 2] = v4.z; hh[i + 3] = v4.w; }
              if (second) { const unsigned ph[8] = {pk_h[0].x, pk_h[0].y, pk_h[0].z, pk_h[0].w, pk_h[1].x, pk_h[1].y, pk_h[1].z, pk_h[1].w};
                  const unsigned pz[8] = {pk_z[0].x, pk_z[0].y, pk_z[0].z, pk_z[0].w, pk_z[1].x, pk_z[1].y, pk_z[1].z, pk_z[1].w};
#pragma unroll
                  for (int i = 0; i < 8; ++i) { hh[2 * i] = (hh[2 * i] + __uint_as_float(ph[i] << 16)) * gelu_tanh_fast(__uint_as_float(pz[i] << 16));
                      hh[2 * i + 1] = (hh[2 * i + 1] + __uint_as_float(ph[i] & 0xffff0000u)) * gelu_tanh_fast(__uint_as_float(pz[i] & 0xffff0000u)); } }
              bf16* yp = ycat + (row0 + t) * D + ch0 + c16;
              *(u32x4*)yp = (u32x4){pk2(hh[0], hh[1]), pk2(hh[2], hh[3]), pk2(hh[4], hh[5]), pk2(hh[6], hh[7])};
              *(u32x4*)(yp + 8) = (u32x4){pk2(hh[8], hh[9]), pk2(hh[10], hh[11]), pk2(hh[12], hh[13]), pk2(hh[14], hh[15])}; }
        }
    }
#undef XL_LOAD
    if (MODE == 0 && fq == 0) { float* sp = sum + (((size_t)(b * 2 + dir) * NSPAN + span) * DL + ch0 + cl) * 2; sp[0] = Ar; sp[1] = Hr; }
}
}

DEV void ph_lru_pass(const Params& P, int bid, int nb, unsigned char* lds, int mode) {
    const int vcu = (bid % 8) * (nb / 8) + bid / 8;
    const int b = vcu >> 5, n = (vcu >> 2) & 7, span = vcu & 3;
    if (mode == 0) lru::sweep2<0>(P, lds, b, n, span, bid, nb); else lru::sweep2<1>(P, lds, b, n, span, bid, nb);
}

#ifndef ATT_DMAG
#define ATT_DMAG 2
#endif
namespace att {
typedef short s16x4 __attribute__((ext_vector_type(4)));
constexpr int KVBLK = 64, QBLK = 32, UROWS = 128;
constexpr int SHM_V = KVBLK * 128 * 2, SHM_K = KVBLK * 128 * 2;
constexpr int NVB = 4, NKB = 3, SHM_K8 = KVBLK * 128;
constexpr int LDS_WS = NVB * SHM_V + NKB * SHM_K8;
constexpr int LDS_TAB = LDS_WS + 8 * 64 * 4;
constexpr int LDS_STG = LDS_TAB + 4 * 384 * 4;
constexpr int TABN = 384, TABOFF = 192;
constexpr float LOG2E = 1.4426950408889634f;
#define KSWZ(row, colB) ((row) * 256 + ((colB) ^ (((row) & 15) << 4)))
#define SBAR() __builtin_amdgcn_sched_barrier(0)
DEV int crow(int r, int hi) { return (r & 3) + 8 * (r >> 2) + 4 * hi; }
DEV unsigned cvtpk(float lo, float hi) { unsigned r; asm volatile("v_cvt_pk_bf16_f32 %0, %1, %2" : "=v"(r) : "v"(lo), "v"(hi)); return r; }
DEV void exp_half(f32x16& p) {
#pragma unroll
    for (int r = 0; r < 16; ++r) p[r] = __builtin_amdgcn_exp2f(p[r]);
}
DEV void finishSM(f32x16& p0, f32x16& p1, float& l_reg, bf16x8& pa0, bf16x8& pa1, bf16x8& pa2, bf16x8& pa3) {
    exp_half(p1);
    float ps = 0.f;
#pragma unroll
    for (int r = 0; r < 16; ++r) ps += p0[r];
#pragma unroll
    for (int r = 0; r < 16; ++r) ps += p1[r];
    l_reg += ps;
#define PK4(P, BASE, OUT) do { unsigned a0 = cvtpk(P[BASE + 0], P[BASE + 1]), a1 = cvtpk(P[BASE + 2], P[BASE + 3]);   \
    unsigned b0 = cvtpk(P[BASE + 4], P[BASE + 5]), b1 = cvtpk(P[BASE + 6], P[BASE + 7]);                              \
    auto r0 = __builtin_amdgcn_permlane32_swap(a0, b0, false, false); auto r1 = __builtin_amdgcn_permlane32_swap(a1, b1, false, false); \
    u32x4 w = {r0[0], r1[0], r0[1], r1[1]}; OUT = *reinterpret_cast<bf16x8*>(&w); } while (0)
    PK4(p0, 0, pa0); PK4(p0, 8, pa1); PK4(p1, 0, pa2); PK4(p1, 8, pa3);
#undef PK4
}
typedef int v8i __attribute__((ext_vector_type(8)));
typedef int v4i __attribute__((ext_vector_type(4)));
DEV int k8_off(int row, int chunk) { return row * 128 + ((chunk ^ ((row >> 1) & 7)) << 4); }
DEV void qkt(f32x16& p0, f32x16& p1, const char* Ks, const v8i& qf, int r32, int hi, int j, int base, const float* tl) {
    const bool nearT = (base > -154) && (base < 122);
    const int c0 = j * 4 + hi * 2;
    const v4i a00 = *reinterpret_cast<const v4i*>(Ks + k8_off(r32, c0)), a01 = *reinterpret_cast<const v4i*>(Ks + k8_off(r32, c0 + 1));
    const v4i a10 = *reinterpret_cast<const v4i*>(Ks + 4096 + k8_off(r32, c0)), a11 = *reinterpret_cast<const v4i*>(Ks + 4096 + k8_off(r32, c0 + 1));
    const v8i ka = __builtin_shufflevector(a00, a01, 0, 1, 2, 3, 4, 5, 6, 7), kb = __builtin_shufflevector(a10, a11, 0, 1, 2, 3, 4, 5, 6, 7);
    if (nearT) {
        const float* t = tl + (base - r32 + TABOFF + 4 * hi);
#pragma unroll
        for (int r = 0; r < 16; ++r) { const int ko = (r & 3) + 8 * (r >> 2); p0[r] = t[ko]; p1[r] = t[32 + ko]; }
        p0 = __builtin_amdgcn_mfma_scale_f32_32x32x64_f8f6f4(ka, qf, p0, 0, 0, 0, 0x7F7F7F7F, 0, 0x7F7F7F7F);
        p1 = __builtin_amdgcn_mfma_scale_f32_32x32x64_f8f6f4(kb, qf, p1, 0, 0, 0, 0x7F7F7F7F, 0, 0x7F7F7F7F);
    } else {
        p0 = __builtin_amdgcn_mfma_scale_f32_32x32x64_f8f6f4(ka, qf, (f32x16){}, 0, 0, 0, 0x7F7F7F7F, 0, 0x7F7F7F7F);
        p1 = __builtin_amdgcn_mfma_scale_f32_32x32x64_f8f6f4(kb, qf, (f32x16){}, 0, 0, 0, 0x7F7F7F7F, 0, 0x7F7F7F7F);
    }
}
DEV int v_st(int k, int c) { const int kk = (k & ~0xC) | ((k & 4) << 1) | ((k & 8) >> 1); return ((kk >> 3) * 4 + (c >> 5)) * 512 + ((kk & 7) * 32 + (c & 31)) * 2; }
DEV int v_rd_base(int lane) { return ((lane & 3) << 3) | (((lane >> 2) & 3) << 6) | (((lane >> 4) & 1) << 5) | (((lane >> 5) & 1) << 8); }
constexpr int v_rd_off(int d0, int ks, int half) { return d0 * 512 + ks * 4096 + half * 2048; }
template <int OFF> DEV s16x4 tr_read(int vb) { s16x4 r; asm volatile("ds_read_b64_tr_b16 %0, %1 offset:%2" : "=&v"(r) : "v"(vb), "i"(OFF) : "memory"); return r; }
template <int D0> DEV void pv_one(f32x16& od, int vb, bf16x8 pa0, bf16x8 pa1, bf16x8 pa2, bf16x8 pa3) {
    const s16x4 l0 = tr_read<v_rd_off(D0, 0, 0)>(vb), h0 = tr_read<v_rd_off(D0, 0, 1)>(vb), l1 = tr_read<v_rd_off(D0, 1, 0)>(vb), h1 = tr_read<v_rd_off(D0, 1, 1)>(vb);
    const s16x4 l2 = tr_read<v_rd_off(D0, 2, 0)>(vb), h2 = tr_read<v_rd_off(D0, 2, 1)>(vb), l3 = tr_read<v_rd_off(D0, 3, 0)>(vb), h3 = tr_read<v_rd_off(D0, 3, 1)>(vb);
    asm volatile("s_waitcnt lgkmcnt(0)" ::: "memory"); SBAR();
#define PK(L, H) (bf16x8){L[0], L[1], L[2], L[3], H[0], H[1], H[2], H[3]}
    od = __builtin_amdgcn_mfma_f32_32x32x16_bf16(pa0, PK(l0, h0), od, 0, 0, 0);
    od = __builtin_amdgcn_mfma_f32_32x32x16_bf16(pa1, PK(l1, h1), od, 0, 0, 0);
    od = __builtin_amdgcn_mfma_f32_32x32x16_bf16(pa2, PK(l2, h2), od, 0, 0, 0);
    od = __builtin_amdgcn_mfma_f32_32x32x16_bf16(pa3, PK(l3, h3), od, 0, 0, 0);
#undef PK
}
DEV void pv_d0(f32x16* o, int vb, bf16x8 pa0, bf16x8 pa1, bf16x8 pa2, bf16x8 pa3) {
    pv_one<0>(o[0], vb, pa0, pa1, pa2, pa3); pv_one<1>(o[1], vb, pa0, pa1, pa2, pa3); pv_one<2>(o[2], vb, pa0, pa1, pa2, pa3); pv_one<3>(o[3], vb, pa0, pa1, pa2, pa3);
}

DEV void attn_unit(const bf16* __restrict__ proj, const unsigned char* __restrict__ qk8, bf16* __restrict__ ycat, int b, int h, int ublk, char* lds, float fsw, float lamv, const float* __restrict__ go) {
    const int tid = phase_tid(), wid = __builtin_amdgcn_readfirstlane(tid >> 6), lane = tid & 63, r32 = lane & 31, hi = lane >> 5;
    const int qb = wid >> 1, j = wid & 1, jcb = j * 128;
    char* V_lds = lds; char* K_lds = lds + NVB * SHM_V;
    LAS unsigned char* ldsl = (LAS unsigned char*)lds;
    float* wsf = (float*)(lds + LDS_WS) + wid * 64;
    const float* tl = (const float*)(lds + LDS_TAB) + h * TABN;
    const long rowbase = (long)b * S;
    const int q0w = ublk * UROWS + qb * QBLK;
    float l_reg = 0.f; f32x16 o[4] = {}; v8i qr;
    { const unsigned char* Qw = qk8 + (size_t)(rowbase + q0w + r32) * 1024 + h * 128 + j * 64 + hi * 32;
      const v4i q0 = *reinterpret_cast<const v4i*>(Qw), q1 = *reinterpret_cast<const v4i*>(Qw + 16); qr = __builtin_shufflevector(q0, q1, 0, 1, 2, 3, 4, 5, 6, 7); }
    const unsigned char* Kh = qk8 + (size_t)rowbase * 1024 + 512 + h * 128; const bf16* Vh = proj + rowbase * NPROJ + 2048 + h * 128;
    constexpr int DMAG = ATT_DMAG;
    const int lw4 = wid & 3;
    const bool issuer = DMAG == 0 || (DMAG == 1 ? wid >= 4 : wid < 4);
    constexpr int NKS = DMAG == 0 ? 1 : 2, NVS = DMAG == 0 ? 2 : 4;
    unsigned koffs[NKS], voffs[NVS]; int kspan[NKS], vspan[NVS];
#pragma unroll
    for (int i = 0; i < NKS; ++i) { kspan[i] = DMAG == 0 ? wid : lw4 + 4 * i; const int krow = 8 * kspan[i] + (lane >> 3), klog = (lane & 7) ^ ((krow >> 1) & 7); koffs[i] = (unsigned)(krow * 1024 + klog * 16); }
#pragma unroll
    for (int i = 0; i < NVS; ++i) { vspan[i] = DMAG == 0 ? wid * 2 + i : lw4 * 4 + i; const int B = vspan[i] * 1024 + lane * 16, sub = B >> 9, kk = (sub >> 2) * 8 + ((B & 511) >> 6), cin = (B & 63) >> 1;
        const int k = (kk & ~0xC) | ((kk & 4) << 1) | ((kk & 8) >> 1), c = (sub & 3) * 32 + cin; voffs[i] = (unsigned)(k * NPROJ * 2 + c * 2); }
    const int vb0 = (int)(uintptr_t)V_lds + v_rd_base(lane);
#define KVDMA(k0, kslot, vslot) do { if (issuer) { const char* kg_ = (const char*)Kh + (size_t)(k0) * 1024; const char* vg_ = (const char*)(Vh + (long)(k0) * NPROJ); \
        _Pragma("unroll") for (int i_ = 0; i_ < NKS; ++i_) __builtin_amdgcn_global_load_lds((const unsigned*)(kg_ + koffs[i_]), (LAS unsigned*)(ldsl + NVB * SHM_V + (kslot) + kspan[i_] * 1024), 16, 0, 0); \
        _Pragma("unroll") for (int i_ = 0; i_ < NVS; ++i_) __builtin_amdgcn_global_load_lds((const unsigned*)(vg_ + voffs[i_]), (LAS unsigned*)(ldsl + (vslot) + vspan[i_] * 1024), 16, 0, 0); } } while (0)
#define WAITV3() do { if (DMAG == 0) asm volatile("s_waitcnt vmcnt(3)" ::: "memory"); else asm volatile("s_waitcnt vmcnt(6)" ::: "memory"); } while (0)
#define WAITV0() asm volatile("s_waitcnt vmcnt(0)" ::: "memory")
#define RBAR() do { asm volatile("s_waitcnt lgkmcnt(0)" ::: "memory"); __builtin_amdgcn_s_barrier(); asm volatile("" ::: "memory"); } while (0)
    bool switched = false, pend = false;
#define CCUPD(base) do { if (!switched && (base) >= 122) { switched = true; pend = true; } } while (0)
#define RESCALE() do { if (pend) { pend = false; l_reg *= fsw; _Pragma("unroll") for (int d = 0; d < 4; ++d) _Pragma("unroll") for (int r = 0; r < 16; ++r) o[d][r] *= fsw; } } while (0)
    bf16x8 pa0, pa1, pa2, pa3; constexpr int NT = S / KVBLK;
    constexpr int SE = 0, SO = 1;
    int vrd = 0, vcur = SHM_V, vnx = 2 * SHM_V, vwr = 3 * SHM_V, kcur = SHM_K8;
#define VROT() do { const int t_ = vrd; vrd = vcur; vcur = vnx; vnx = vwr; vwr = t_; kcur = kcur == 2 * SHM_K8 ? 0 : kcur + SHM_K8; } while (0)
#define KDST() (kcur >= SHM_K8 ? kcur - SHM_K8 : 2 * SHM_K8)
    if (wid < 4) __builtin_amdgcn_s_setprio(1);
    if (wid < 4) {
    f32x16 pA0, pA1, pB0, pB1;
    KVDMA(0, 0, 0); KVDMA(KVBLK, SHM_K8, SHM_V); WAITV3(); RBAR();
    { const int base = 0 - q0w; CCUPD(base); qkt(pA0, pA1, K_lds, qr, r32, hi, j, base, tl); } exp_half(pA0);
    KVDMA(2 * KVBLK, 2 * SHM_K8, 2 * SHM_V);
    WAITV3(); RBAR();
    for (int jt = 1; jt + 1 < NT; jt += 2) {
        SBAR(); { const int base = jt * KVBLK - q0w; CCUPD(base); qkt(pB0, pB1, K_lds + kcur, qr, r32, hi, j, base, tl); }
        finishSM(pA0, pA1, l_reg, pa0, pa1, pa2, pa3); SBAR();
        KVDMA((jt + 2) * KVBLK, KDST(), vwr); SBAR();
        pv_d0(o, vb0 + vrd, pa0, pa1, pa2, pa3); exp_half(pB0); RESCALE();
        WAITV3();
        RBAR(); VROT();
        SBAR(); { const int base = (jt + 1) * KVBLK - q0w; CCUPD(base); qkt(pA0, pA1, K_lds + kcur, qr, r32, hi, j, base, tl); }
        finishSM(pB0, pB1, l_reg, pa0, pa1, pa2, pa3); SBAR();
        if (jt + 3 < NT) KVDMA((jt + 3) * KVBLK, KDST(), vwr); SBAR();
        pv_d0(o, vb0 + vrd, pa0, pa1, pa2, pa3); exp_half(pA0); RESCALE();
        if (jt + 3 < NT) WAITV3(); else WAITV0();
        RBAR(); VROT();
    }
    SBAR(); { const int base = (NT - 1) * KVBLK - q0w; CCUPD(base); qkt(pB0, pB1, K_lds + kcur, qr, r32, hi, j, base, tl); }
    finishSM(pA0, pA1, l_reg, pa0, pa1, pa2, pa3); SBAR();
    pv_d0(o, vb0 + vrd, pa0, pa1, pa2, pa3); exp_half(pB0); RESCALE();
    finishSM(pB0, pB1, l_reg, pa0, pa1, pa2, pa3); SBAR();
    pv_d0(o, vb0 + vcur, pa0, pa1, pa2, pa3);
    } else {
    f32x16 pC0, pC1;
#define RESC_NOW(base) do { if (!switched && (base) >= 122) { switched = true; l_reg *= fsw; _Pragma("unroll") for (int d = 0; d < 4; ++d) _Pragma("unroll") for (int r = 0; r < 16; ++r) o[d][r] *= fsw; } } while (0)
    KVDMA(0, 0, 0); KVDMA(KVBLK, SHM_K8, SHM_V); WAITV3(); RBAR();
    { const int base = 0 - q0w; qkt(pC0, pC1, K_lds, qr, r32, hi, j, base, tl); } exp_half(pC0); finishSM(pC0, pC1, l_reg, pa0, pa1, pa2, pa3);
    KVDMA(2 * KVBLK, 2 * SHM_K8, 2 * SHM_V);
    WAITV3(); RBAR();
    for (int jt = 1; jt + 1 < NT; jt += 2) {
        SBAR(); KVDMA((jt + 2) * KVBLK, KDST(), vwr); SBAR();
        pv_d0(o, vb0 + vrd, pa0, pa1, pa2, pa3);
        { const int base = jt * KVBLK - q0w; RESC_NOW(base); SBAR(); qkt(pC0, pC1, K_lds + kcur, qr, r32, hi, j, base, tl); }
        exp_half(pC0); finishSM(pC0, pC1, l_reg, pa0, pa1, pa2, pa3); SBAR();
        WAITV3();
        RBAR(); VROT();
        SBAR(); if (jt + 3 < NT) KVDMA((jt + 3) * KVBLK, KDST(), vwr); SBAR();
        pv_d0(o, vb0 + vrd, pa0, pa1, pa2, pa3);
        { const int base = (jt + 1) * KVBLK - q0w; RESC_NOW(base); SBAR(); qkt(pC0, pC1, K_lds + kcur, qr, r32, hi, j, base, tl); }
        exp_half(pC0); finishSM(pC0, pC1, l_reg, pa0, pa1, pa2, pa3); SBAR();
        if (jt + 3 < NT) WAITV3(); else WAITV0();
        RBAR(); VROT();
    }
    pv_d0(o, vb0 + vrd, pa0, pa1, pa2, pa3);
    { const int base = (NT - 1) * KVBLK - q0w; RESC_NOW(base); SBAR(); qkt(pC0, pC1, K_lds + kcur, qr, r32, hi, j, base, tl); }
    exp_half(pC0); finishSM(pC0, pC1, l_reg, pa0, pa1, pa2, pa3); SBAR();
    pv_d0(o, vb0 + vcur, pa0, pa1, pa2, pa3);
#undef RESC_NOW
    }
#undef VROT
#undef KVDMA
#undef WAITV3
#undef WAITV0
#undef RBAR
#undef KDST
#undef CCUPD
#undef RESCALE
    __builtin_amdgcn_s_setprio(0);
    { auto rr = __builtin_amdgcn_permlane32_swap(__float_as_uint(l_reg), __float_as_uint(l_reg), false, false); l_reg = __uint_as_float(rr[0]) + __uint_as_float(rr[1]); }
    if (hi == 0) wsf[r32] = l_reg;
    asm volatile("s_waitcnt lgkmcnt(0)" ::: "memory");
    __syncthreads();
    float* X = (float*)lds + qb * 4096;
    const float own_sc = j == 1 ? lamv : 1.f;
#define XPUT(R0) do { _Pragma("unroll") for (int r = R0; r < R0 + 8; ++r) { const float sc = __builtin_amdgcn_rcpf(wsf[crow(r, hi)]) * own_sc; \
            _Pragma("unroll") for (int d0 = 0; d0 < 4; ++d0) X[(d0 * 16 + r) * 64 + lane] = o[d0][r] * sc; asm volatile("" ::: "memory"); } } while (0)
    if (j == 0) XPUT(8); else XPUT(0);
#undef XPUT
    __syncthreads();
    {
        float gv[4];
#pragma unroll
        for (int d0 = 0; d0 < 4; ++d0) gv[d0] = go[32 * d0 + r32] * (1.f - LAM_INIT);
        bf16* stg = (bf16*)(lds + LDS_STG) + qb * 4096;
        const float sgn = j == 0 ? 1.f : -1.f;
#define XFIN(R0) do { _Pragma("unroll") for (int r = R0; r < R0 + 8; ++r) { const float ri = __builtin_amdgcn_rcpf(wsf[crow(r, hi)]) * own_sc; float v[4]; float ss = 0.f; \
            _Pragma("unroll") for (int d0 = 0; d0 < 4; ++d0) { v[d0] = sgn * (o[d0][r] * ri - X[(d0 * 16 + r) * 64 + lane]); ss += v[d0] * v[d0]; } \
            ss += __shfl_xor(ss, 1); ss += __shfl_xor(ss, 2); ss += __shfl_xor(ss, 4); ss += __shfl_xor(ss, 8); ss += __shfl_xor(ss, 16); \
            const float rs = rsqrtf(ss * (1.f / 128.f) + EPS); const int q = crow(r, hi); \
            _Pragma("unroll") for (int d0 = 0; d0 < 4; ++d0) stg[q * 128 + d0 * 32 + r32] = (bf16)f2bf(v[d0] * rs * gv[d0]); asm volatile("" ::: "memory"); } } while (0)
        if (j == 0) XFIN(0); else XFIN(8);
#undef XFIN
        asm volatile("s_waitcnt lgkmcnt(0)" ::: "memory");
        bf16* Ow = ycat + (rowbase + q0w) * D + 512 + h * 128;
#pragma unroll
        for (int i = 0; i < 4; ++i) { const int row = 16 * j + i * 4 + (lane >> 4), ch = lane & 15;
            const u32x4 v = *(const u32x4*)(stg + row * 128 + ch * 8); *(u32x4*)(Ow + (long)row * D + ch * 8) = v; }
    }
    __syncthreads();
}
#undef KSWZ
#undef SBAR
}

DEV void ph_attn(const Params& P, int bid, int nb, unsigned char* lds_, int i0 = 0, int i1 = 4) {
    if (i0 >= i1) return;
    const int tid = phase_tid(), lane = tid & 63;
    char* lds = (char*)lds_;
    const bf16* proj = (const bf16*)(P.ws + WS_PROJ); bf16* ycat = (bf16*)(P.ws + WS_YCAT);
    const float* lq = P.in[15]; const float* go = P.in[16]; const float* rb = P.in[17];
    const float s01 = wave_sum(lq[lane] * lq[64 + lane]), s23 = wave_sum(lq[128 + lane] * lq[192 + lane]);
    const float lamv = __expf(s01) - __expf(s23) + LAM_INIT;
    __syncthreads();
    { float* tabs = (float*)(lds + att::LDS_TAB);
      for (int i = tid; i < 4 * att::TABN; i += NTHR) { const int hd = i / att::TABN, rel = i % att::TABN - att::TABOFF;
          tabs[i] = (rb[t5_bucket(rel) * NH + hd] - rb[15 * NH + hd]) * att::LOG2E; } }
    __syncthreads();
    const int vcu = (bid % 8) * (nb / 8) + bid / 8, xg = vcu >> 5, c = vcu & 31;
    for (int i = i0; i < i1; ++i) {
        const int bh = xg * 4 + i, b = bh >> 2, hd = bh & 3;
        const float fsw = __expf(rb[15 * NH + hd] - rb[31 * NH + hd]);
        att::attn_unit(proj, (const unsigned char*)(P.ws + WS_QK8), ycat, b, hd, c, lds, fsw, lamv, go);
    }
}

DEV void ph_outproj(const Params& P, int bid, int nb, unsigned char* lds) {
    pg8::StaticOrder S; S.init((const bf16*)(P.ws + WS_YCAT), (const bf16*)(P.ws + WS_WOUT), T, D, D, nb, bid);
    pg8::EpiResGate E{P.in[0], (bf16*)P.out + X1_OFF, X1_LD, (const float*)(P.ws + WS_MOD)};
    pg8::gemm_phase<pg8::EpiResGate, pg8::StaticOrder, true, false>((LAS unsigned char*)lds, D * 2, S, E);
}

DEV void ph_h2(const Params& P, int bid, int nb, unsigned char* lds) {
    const int tid = phase_tid(), lane = tid & 63, wave = tid >> 6;
    const bf16* x1 = (const bf16*)P.out + X1_OFF; const float* g2 = P.in[19]; const float* wr = P.in[20]; const float* mod = (const float*)(P.ws + WS_MOD);
    unsigned char* h2 = (unsigned char*)(P.ws + WS_H2); float* aff = (float*)(P.ws + WS_AFF);
    float* gm = (float*)lds;
    float* sh = gm + D;
    bf16x8* Whi = (bf16x8*)(lds + 8192);
    bf16x8* Wlo = Whi + 32 * 64;
    float* rsd = (float*)(lds + 8192 + 2 * 32 * 64 * 16) + wave * 16;
    for (int blk = (bid & 7) * (nb / 8) + (bid >> 3); blk < T / 128; blk += T / 128) {
        const int b = (blk * 128) >> 12;
        __syncthreads();
        { const float* scl = mod + b * 6 * D + 4 * D; const float* shf = mod + b * 6 * D + 3 * D;
          for (int k = tid; k < D; k += NTHR) { gm[k] = g2[k] * (1.f + scl[k]); sh[k] = shf[k]; }
          for (int q = tid; q < 32 * 64; q += NTHR) { const int ks = q >> 6, l = q & 63, e = l & 15, kg = l >> 4; unsigned hi4[4], lo4[4];
#pragma unroll
              for (int jj = 0; jj < 4; ++jj) { const float w0 = wr[(size_t)(ks * 32 + kg * 8 + 2 * jj) * NE + e], w1 = wr[(size_t)(ks * 32 + kg * 8 + 2 * jj + 1) * NE + e];
                  const unsigned h0 = f2bf(w0), h1 = f2bf(w1); hi4[jj] = h0 | (h1 << 16);
                  lo4[jj] = pk2(w0 - __uint_as_float(h0 << 16), w1 - __uint_as_float(h1 << 16)); }
              const u32x4 vh = {hi4[0], hi4[1], hi4[2], hi4[3]}, vl = {lo4[0], lo4[1], lo4[2], lo4[3]};
              Whi[q] = *reinterpret_cast<const bf16x8*>(&vh); Wlo[q] = *reinterpret_cast<const bf16x8*>(&vl); } }
        __syncthreads();
        const int r0 = blk * 128 + wave * 16;
        const int row = lane & 15, kg = lane >> 4;
        const bf16* xr = x1 + (size_t)(r0 + row) * X1_LD + kg * 8;
        unsigned char* hr = h2 + (size_t)(r0 + row) * D + kg * 8;
        u32x4 xv[32];
#pragma unroll
        for (int ks = 0; ks < 32; ++ks) xv[ks] = *(const u32x4*)(xr + ks * 32);
        float ss = 0.f;
#pragma unroll
        for (int ks = 0; ks < 32; ++ks) { const unsigned xw[4] = {xv[ks].x, xv[ks].y, xv[ks].z, xv[ks].w};
#pragma unroll
            for (int i = 0; i < 4; ++i) { const float a0 = __uint_as_float(xw[i] << 16), a1 = __uint_as_float(xw[i] & 0xffff0000u); ss += a0 * a0 + a1 * a1; } }
        ss += __shfl_xor(ss, 16); ss += __shfl_xor(ss, 32);
        const float rstd = rsqrtf(ss * (1.f / D) + EPS);
        f32x4 acc = {0.f, 0.f, 0.f, 0.f};
        const LAS float* gml = (const LAS float*)(LAS unsigned char*)lds + kg * 8;
        const LAS bf16x8* wl = (const LAS bf16x8*)((LAS unsigned char*)lds + 8192) + lane;
        asm volatile("" : "+v"(gml), "+v"(wl));
#pragma unroll
        for (int ks = 0; ks < 32; ++ks) {
            unsigned xw0 = xv[ks].x, xw1 = xv[ks].y, xw2 = xv[ks].z, xw3 = xv[ks].w;
            asm volatile("" : "+v"(xw0), "+v"(xw1), "+v"(xw2), "+v"(xw3));
            const unsigned xw[4] = {xw0, xw1, xw2, xw3};
            const f32x4 g0 = *(const LAS f32x4*)(gml + ks * 32), g1 = *(const LAS f32x4*)(gml + ks * 32 + 4), s0 = *(const LAS f32x4*)(gml + D + ks * 32), s1 = *(const LAS f32x4*)(gml + D + ks * 32 + 4);
            const float gg[8] = {g0.x, g0.y, g0.z, g0.w, g1.x, g1.y, g1.z, g1.w}, ssv[8] = {s0.x, s0.y, s0.z, s0.w, s1.x, s1.y, s1.z, s1.w};
            float o[8]; unsigned hi4[4], lo4[4];
#pragma unroll
            for (int i = 0; i < 4; ++i) { o[2 * i] = __uint_as_float(xw[i] << 16) * rstd * gg[2 * i] + ssv[2 * i]; o[2 * i + 1] = __uint_as_float(xw[i] & 0xffff0000u) * rstd * gg[2 * i + 1] + ssv[2 * i + 1];
                const unsigned h0 = f2bf(o[2 * i]), h1 = f2bf(o[2 * i + 1]); hi4[i] = h0 | (h1 << 16);
                lo4[i] = pk2(o[2 * i] - __uint_as_float(h0 << 16), o[2 * i + 1] - __uint_as_float(h1 << 16)); }
            *(u32x2*)(hr + ks * 32) = (u32x2){pk4_fp8(o[0], o[1], o[2], o[3]), pk4_fp8(o[4], o[5], o[6], o[7])};
            const u32x4 vh = {hi4[0], hi4[1], hi4[2], hi4[3]}, vl = {lo4[0], lo4[1], lo4[2], lo4[3]};
            const bf16x8 ah = *reinterpret_cast<const bf16x8*>(&vh), al = *reinterpret_cast<const bf16x8*>(&vl);
            const bf16x8 bh = wl[ks * 64], bl = wl[32 * 64 + ks * 64];
            acc = __builtin_amdgcn_mfma_f32_16x16x32_bf16(ah, bh, acc, 0, 0, 0);
            acc = __builtin_amdgcn_mfma_f32_16x16x32_bf16(ah, bl, acc, 0, 0, 0);
            acc = __builtin_amdgcn_mfma_f32_16x16x32_bf16(al, bh, acc, 0, 0, 0);
            asm volatile("" ::: "memory");
        }
        f32x4 pr;
#pragma unroll
        for (int rg = 0; rg < 4; ++rg) { float v = acc[rg], mx = v;
            mx = fmaxf(mx, __shfl_xor(mx, 1)); mx = fmaxf(mx, __shfl_xor(mx, 2)); mx = fmaxf(mx, __shfl_xor(mx, 4)); mx = fmaxf(mx, __shfl_xor(mx, 8));
            const float pe = __expf(v - mx); float se = pe;
            se += __shfl_xor(se, 1); se += __shfl_xor(se, 2); se += __shfl_xor(se, 4); se += __shfl_xor(se, 8);
            pr[rg] = pe / se; }
        *(f32x4*)(aff + ((size_t)((r0 >> 12) * NE + row)) * S + (r0 & (S - 1)) + kg * 4) = pr;
    }
}

DEV unsigned block_excl_scan(unsigned v, unsigned* sh  , int tid, unsigned& total) {
    const int lane = tid & 63, wave = tid >> 6;
    unsigned x = v;
#pragma unroll
    for (int o = 1; o < 64; o <<= 1) { const unsigned y = __shfl_up(x, o); if (lane >= o) x += y; }
    __syncthreads();
    if (lane == 63) sh[wave] = x;
    __syncthreads();
    unsigned base = 0, tot = 0;
#pragma unroll
    for (int w = 0; w < NWAVE; ++w) { const unsigned s = sh[w]; if (w < wave) base += s; tot += s; }
    total = tot;
    return base + x - v;
}
DEV void topk_be(const Params& P, const int b, const int e, const int pm, unsigned char* lds, LAS int* rowtab, LAS float* gvtab) {
    const int tid = phase_tid();
    const float* aff = (const float*)(P.ws + WS_AFF);
    int* sel = (int*)(P.ws + WS_SEL);
    unsigned* hist = (unsigned*)lds;
    unsigned* sh = hist + 1024;
    unsigned* sh2 = sh + 16;
    {
        unsigned key[8];
        { const f32x4* ap = (const f32x4*)(aff + ((size_t)(b * NE + e)) * S + tid * 8); const f32x4 k0 = ap[0], k1 = ap[1];
          key[0] = __float_as_uint(k0.x); key[1] = __float_as_uint(k0.y); key[2] = __float_as_uint(k0.z); key[3] = __float_as_uint(k0.w); key[4] = __float_as_uint(k1.x); key[5] = __float_as_uint(k1.y); key[6] = __float_as_uint(k1.z); key[7] = __float_as_uint(k1.w); }
        unsigned prefix = 0, krem = CAP;
#pragma unroll
        for (int pass = 0; pass < 3; ++pass) {
            const int shift = 20 - 10 * pass;
            __syncthreads();
            hist[tid] = 0u; hist[tid + 512] = 0u;
            __syncthreads();
#pragma unroll
            for (int i = 0; i < 8; ++i) { const bool in = (pass == 0) || ((key[i] >> (shift + 10)) == (prefix >> (shift + 10))); if (in) atomicAdd(&hist[(key[i] >> shift) & 1023u], 1u); }
            __syncthreads();
            if (tid < 64) {
                const int l = tid; unsigned c16[16]; unsigned s_ = 0;
#pragma unroll
                for (int q = 0; q < 16; ++q) { c16[q] = hist[1023 - 16 * l - q]; s_ += c16[q]; }
                unsigned inc = s_;
#pragma unroll
                for (int o = 1; o < 64; o <<= 1) { const unsigned y = __shfl_up(inc, o); if (l >= o) inc += y; }
                const unsigned exc = inc - s_;
                if (exc < krem && inc >= krem) { unsigned cum = exc; int binsel = 0; unsigned kr = krem;
#pragma unroll
                    for (int q = 0; q < 16; ++q) { if (cum < krem && cum + c16[q] >= krem) { binsel = 1023 - 16 * l - q; kr = krem - cum; } cum += c16[q]; }
                    sh2[0] = (unsigned)binsel; sh2[1] = kr; }
            }
            __syncthreads();
            prefix |= sh2[0] << shift; krem = sh2[1];
        }
        unsigned ng = 0, neq = 0;
#pragma unroll
        for (int i = 0; i < 8; ++i) { ng += key[i] > prefix ? 1u : 0u; neq += key[i] == prefix ? 1u : 0u; }
        unsigned tot;
        const unsigned eqbase = block_excl_scan(neq, sh, tid, tot);
        unsigned nsel = 0; unsigned selmask = 0; unsigned er = eqbase;
#pragma unroll
        for (int i = 0; i < 8; ++i) { bool s_ = key[i] > prefix; if (key[i] == prefix) { s_ = er < krem; ++er; } if (s_) { selmask |= 1u << i; ++nsel; } }
        unsigned pos = block_excl_scan(nsel, sh, tid, tot);
        int* selp = sel + ((size_t)(b * NE + e)) * S + tid * 8;
        const bool mine = (tid >> 8) == pm;
        int sv[8];
#pragma unroll
        for (int i = 0; i < 8; ++i) {
            if (selmask & (1u << i)) { const unsigned lp = pos - (unsigned)pm * 256u; if (lp < 256u) { rowtab[lp] = tid * 8 + i; gvtab[lp] = __uint_as_float(key[i]); } sv[i] = (int)pos; ++pos; }
            else sv[i] = -1;
        }
        if (mine) { *(i32x4*)selp = (i32x4){sv[0], sv[1], sv[2], sv[3]}; *(i32x4*)(selp + 4) = (i32x4){sv[4], sv[5], sv[6], sv[7]}; }
    }
    __syncthreads();
}

DEV void ph_moe_up(const Params& P, int bid, int nb, unsigned char* lds) {
    const int vcu = (bid % 8) * (nb / 8) + bid / 8;
    pg8::MoeUpOrder S; S.e = vcu >> 4; S.b = (vcu & 15) >> 1; S.pm = vcu & 1; S.g = S.b * NE + S.e;
    S.h2 = (const char*)(P.ws + WS_H2); S.w1 = (const char*)(P.ws + WS_W1); S.w3 = (const char*)(P.ws + WS_W3);
    LAS int* rowtab = (LAS int*)((LAS unsigned char*)lds + LDS_MISC + 1024);
    LAS float* gvtab = (LAS float*)((LAS unsigned char*)lds + LDS_MISC + 2048);
    __syncthreads();
    topk_be(P, S.b, S.e, S.pm, lds, rowtab, gvtab);
    S.rowtab = rowtab;
    pg8::EpiSwiGLU E{(unsigned char*)(P.ws + WS_HB), gvtab};
    pg8::gemm_phase<pg8::EpiSwiGLU, pg8::MoeUpOrder, true, true, true>((LAS unsigned char*)lds, D, S, E);
}

DEV void ph_moe_down(const Params& P, int bid, int nb, unsigned char* lds) {
    const int vcu = (bid % 8) * (nb / 8) + bid / 8;
    pg8::MoeDownOrder S; S.e = vcu >> 4; S.pm = vcu & 1; S.g = ((vcu & 15) >> 1) * NE + S.e;
    S.hb = (const char*)(P.ws + WS_HB); S.w2 = (const char*)(P.ws + WS_W2);
    pg8::EpiScaleRow E{(unsigned char*)(P.ws + WS_YB)};
    pg8::gemm_phase<pg8::EpiScaleRow, pg8::MoeDownOrder, true, false, true>((LAS unsigned char*)lds, D, S, E);
}

DEV void ph_final(const Params& P, int bid, int nb, bool probe = false) {
    const int tid = phase_tid(), lane = tid & 63, wave = tid >> 6;
    const float* mod = (const float*)(P.ws + WS_MOD); const int* sel = (const int*)(P.ws + WS_SEL); const unsigned char* yb = (const unsigned char*)(P.ws + WS_YB);
    float* out = P.out; float* dst = probe ? (float*)(P.ws + WS_PROJ) : P.out;
    const int gw = bid * NWAVE + wave, ngw = nb * NWAVE;
    for (int row0 = gw; row0 < T; row0 += 2 * ngw) {
        const int rowA = row0, rowB = row0 + ngw < T ? row0 + ngw : row0; const bool hasB = row0 + ngw < T;
        const int bA = rowA >> 12, bB = rowB >> 12;
        u32x2 xa[4], xb[4];
#pragma unroll
        for (int j = 0; j < 4; ++j) { xa[j] = ((const u32x2*)((const bf16*)out + (size_t)rowA * X1_LD + X1_OFF) + lane)[64 * j]; xb[j] = ((const u32x2*)((const bf16*)out + (size_t)rowB * X1_LD + X1_OFF) + lane)[64 * j]; }
        const int e16 = lane & 15;
        const int cA = sel[((size_t)(bA * NE + e16)) * S + (rowA & (S - 1))], cB = sel[((size_t)(bB * NE + e16)) * S + (rowB & (S - 1))];
        unsigned mA = (unsigned)(__ballot(cA >= 0) & 0xFFFFull), mB = (unsigned)(__ballot(cB >= 0) & 0xFFFFull);
        float accA[16], accB[16];
#pragma unroll
        for (int i = 0; i < 16; ++i) { accA[i] = 0.f; accB[i] = 0.f; }
#define GATHER4(M, CV, BB, W) do { _Pragma("unroll") for (int k_ = 0; k_ < 4; ++k_) { \
            if (M) { const int e_ = __builtin_ctz(M); M &= M - 1; const int c_ = __builtin_amdgcn_readlane(CV, e_); \
                const unsigned char* y_ = yb + ((size_t)((BB) * NE + e_) * CAP + c_) * D + 4 * lane; \
                _Pragma("unroll") for (int j = 0; j < 4; ++j) W[k_][j] = *(const int*)(y_ + 256 * j); } \
            else { _Pragma("unroll") for (int j = 0; j < 4; ++j) W[k_][j] = 0; } } } while (0)
#define ACCUM4(ACC, W) do { _Pragma("unroll") for (int k_ = 0; k_ < 4; ++k_) { _Pragma("unroll") for (int j = 0; j < 4; ++j) { \
            const f32x2 p0 = __builtin_amdgcn_cvt_pk_f32_fp8(W[k_][j], false), p1 = __builtin_amdgcn_cvt_pk_f32_fp8(W[k_][j], true); \
            ACC[4 * j] += p0.x; ACC[4 * j + 1] += p0.y; ACC[4 * j + 2] += p1.x; ACC[4 * j + 3] += p1.y; } } } while (0)
        if (!hasB) mB = 0;
        while (mA | mB) {
            int wA[4][4], wB[4][4];
            GATHER4(mA, cA, bA, wA); GATHER4(mB, cB, bB, wB);
            ACCUM4(accA, wA); ACCUM4(accB, wB);
        }
#undef GATHER4
#undef ACCUM4
        const float* gA = mod + bA * 6 * D + 5 * D; const float* gB = mod + bB * 6 * D + 5 * D;
#pragma unroll
        for (int j = 0; j < 4; ++j) { const int k = 4 * lane + 256 * j; const f32x4 g = *(const f32x4*)(gA + k) * 0.03125f;
            f32x4 v = {__uint_as_float(xa[j].x << 16), __uint_as_float(xa[j].x & 0xffff0000u), __uint_as_float(xa[j].y << 16), __uint_as_float(xa[j].y & 0xffff0000u)};
            v.x += g.x * accA[4 * j]; v.y += g.y * accA[4 * j + 1]; v.z += g.z * accA[4 * j + 2]; v.w += g.w * accA[4 * j + 3]; __builtin_nontemporal_store(v, (f32x4*)(dst + (size_t)rowA * D + k)); }
        if (hasB) {
#pragma unroll
            for (int j = 0; j < 4; ++j) { const int k = 4 * lane + 256 * j; const f32x4 g = *(const f32x4*)(gB + k) * 0.03125f;
                f32x4 v = {__uint_as_float(xb[j].x << 16), __uint_as_float(xb[j].x & 0xffff0000u), __uint_as_float(xb[j].y << 16), __uint_as_float(xb[j].y & 0xffff0000u)};
                v.x += g.x * accB[4 * j]; v.y += g.y * accB[4 * j + 1]; v.z += g.z * accB[4 * j + 2]; v.w += g.w * accB[4 * j + 3]; __builtin_nontemporal_store(v, (f32x4*)(dst + (size_t)rowB * D + k)); }
        }
    }
}

constexpr int NPHASE = 11;
template <int PH> DEV void run_phase(const Params& P, int bid, int nb, unsigned char* lds) {
    if constexpr (PH == 0) { ph_prep(P, bid, nb, lds); ph_mod(P, bid, nb, lds); }
    if constexpr (PH == 1) ph_h(P, bid, nb);
    if constexpr (PH == 2) ph_inproj(P, bid, nb, lds);
    if constexpr (PH == 3) {
        const int slot = (bid % 8) & 3;
        ph_attn(P, bid, nb, lds, 0, slot); ph_lru_pass(P, bid, nb, lds, 0); ph_attn(P, bid, nb, lds, slot, 4); }
    if constexpr (PH == 4) ph_lru_pass(P, bid, nb, lds, 1);
    if constexpr (PH == 5) ph_outproj(P, bid, nb, lds);
    if constexpr (PH == 6) ph_h2(P, bid, nb, lds);
    if constexpr (PH == 8) ph_moe_up(P, bid, nb, lds);
    if constexpr (PH == 9) ph_moe_down(P, bid, nb, lds);
    if constexpr (PH == 10) ph_final(P, bid, nb);
    if constexpr (PH == 20) ph_lru_pass(P, bid, nb, lds, 0);
    if constexpr (PH == 21) ph_lru_pass(P, bid, nb, lds, 1);
    if constexpr (PH == 22) ph_attn(P, bid, nb, lds);
    if constexpr (PH == 23) ph_qknorm_conv(P, bid, nb, true);
    if constexpr (PH == 24) ph_final(P, bid, nb, true);
}
#if MK_SINGLE
__global__ void __launch_bounds__(NTHR, 2) mega(Params P) {
    extern __shared__ __attribute__((aligned(16))) unsigned char lds[];
    const int bid = blockIdx.x, nb = gridDim.x;
    volatile LAS unsigned* MISC = (volatile LAS unsigned*)((LAS unsigned char*)lds + LDS_MISC);
    tid_table_init();
    for (int u = threadIdx.x; u < 64; u += NTHR) MISC[u] = 0u;
    __syncthreads();
    (void)xcd_barrier_post((unsigned*)(P.ws + WS_CTL) + 4096, MISC + 8);
    (void)xcd_barrier_post((unsigned*)(P.ws + WS_CTL) + 4096 + (1 + (bid & 7)) * XCD_BAR_WORDS, MISC + 16);
#define SEAM() do { XcdBarrier bar_; bar_.bar = (unsigned*)(P.ws + WS_CTL) + 4096; bar_.x = xb_xcc_id(); \
        bar_.st = (volatile LAS unsigned*)((LAS unsigned char*)lds + LDS_MISC) + 8; bar_.G = gridDim.x; xcd_barrier(bar_); } while (0)
#define GSEAM() do { XcdBarrier bar_; bar_.bar = (unsigned*)(P.ws + WS_CTL) + 4096 + (1 + (blockIdx.x & 7)) * XCD_BAR_WORDS; bar_.x = xb_xcc_id(); \
        bar_.st = (volatile LAS unsigned*)((LAS unsigned char*)lds + LDS_MISC) + 16; bar_.G = gridDim.x / 8; xcd_barrier(bar_); } while (0)
    run_phase<0>(P, bid, nb, lds); SEAM();
    run_phase<1>(P, bid, nb, lds); GSEAM();
    run_phase<2>(P, bid, nb, lds); GSEAM();
    run_phase<3>(P, bid, nb, lds); GSEAM();
    run_phase<4>(P, bid, nb, lds); GSEAM();
    run_phase<5>(P, bid, nb, lds); GSEAM();
    run_phase<6>(P, bid, nb, lds); SEAM();
    run_phase<8>(P, bid, nb, lds);
    asm volatile("s_waitcnt vmcnt(0)" ::: "memory"); __syncthreads(); if (threadIdx.x == 0) asm volatile("buffer_inv sc0" ::: "memory"); __syncthreads();
    run_phase<9>(P, bid, nb, lds); SEAM();
#undef SEAM
#undef GSEAM
    run_phase<10>(P, bid, nb, lds);
}
#else
template <int PH> __global__ void __launch_bounds__(NTHR, 2) phase_kernel(Params P) {
    extern __shared__ __attribute__((aligned(16))) unsigned char lds[];
    tid_table_init(); __syncthreads();
    run_phase<PH>(P, blockIdx.x, gridDim.x, lds);
}
#ifndef PROBE_PH
#define PROBE_PH -1
#endif
#ifndef PROBE_REP
#define PROBE_REP 1
#endif
template <int PH> static void launch_phase(int grid, hipStream_t stream, const Params& p) {
    static bool attr = false;
    if (!attr) { (void)hipFuncSetAttribute((const void*)phase_kernel<PH>, hipFuncAttributeMaxDynamicSharedMemorySize, LDS_BYTES); attr = true; }
    hipLaunchKernelGGL(phase_kernel<PH>, dim3(grid), dim3(NTHR), LDS_BYTES, stream, p);
    if (PROBE_PH == PH) for (int r = 0; r < PROBE_REP; ++r) hipLaunchKernelGGL(phase_kernel<PH>, dim3(grid), dim3(NTHR), LDS_BYTES, stream, p);
    if (PH == 3 && PROBE_PH == 20) for (int r = 0; r < PROBE_REP; ++r) hipLaunchKernelGGL(phase_kernel<20>, dim3(grid), dim3(NTHR), LDS_BYTES, stream, p);
    if (PH == 4 && PROBE_PH == 21) for (int r = 0; r < PROBE_REP; ++r) hipLaunchKernelGGL(phase_kernel<21>, dim3(grid), dim3(NTHR), LDS_BYTES, stream, p);
    if (PH == 4 && PROBE_PH == 22) for (int r = 0; r < PROBE_REP; ++r) hipLaunchKernelGGL(phase_kernel<22>, dim3(grid), dim3(NTHR), LDS_BYTES, stream, p);
    if (PH == 3 && PROBE_PH == 23) for (int r = 0; r < PROBE_REP; ++r) hipLaunchKernelGGL(phase_kernel<23>, dim3(grid), dim3(NTHR), LDS_BYTES, stream, p);
    if (PH == 9 && PROBE_PH == 24) for (int r = 0; r < PROBE_REP; ++r) hipLaunchKernelGGL(phase_kernel<24>, dim3(grid), dim3(NTHR), LDS_BYTES, stream, p);
}
#endif

extern "C" void kernel_launch(void* const* d_in, const int* in_sizes, int n_in, void* d_out, int out_size, void* d_ws, size_t ws_size, hipStream_t stream) {
    static int grid = 0;
    if (grid == 0) {
        if (n_in != 24 || out_size != T * D || ws_size < WS_END) { fprintf(stderr, "kernel_launch: unexpected shapes (n_in %d out %d ws %zu)\n", n_in, out_size, ws_size); grid = -1; return; }
        int dev = 0, cus = 0;
        if (hipGetDevice(&dev) != hipSuccess || hipDeviceGetAttribute(&cus, hipDeviceAttributeMultiprocessorCount, dev) != hipSuccess) { grid = -1; return; }
#if MK_SINGLE
        if (hipFuncSetAttribute((const void*)mega, hipFuncAttributeMaxDynamicSharedMemorySize, LDS_BYTES) != hipSuccess) { fprintf(stderr, "kernel_launch: hipFuncSetAttribute failed\n"); grid = -1; return; }
        int per_cu = 0;
        (void)hipOccupancyMaxActiveBlocksPerMultiprocessor(&per_cu, (const void*)mega, NTHR, LDS_BYTES);
        (void)hipGetLastError();
#endif
        grid = cus;
        if (grid != 256) { fprintf(stderr, "kernel_launch: this build needs a 256-CU device (got %d)\n", cus); grid = -1; return; }
    }
    if (grid < 0) return;
    (void)hipMemsetAsync((char*)d_ws + WS_CTL, 0, 144 * 1024, stream);
    Params p{};
    for (int i = 0; i < 24; ++i) p.in[i] = (const float*)d_in[i];
    p.out = (float*)d_out; p.ws = (unsigned char*)d_ws;
#if MK_SINGLE
    hipLaunchKernelGGL(mega, dim3(grid), dim3(NTHR), LDS_BYTES, stream, p);
#else
    launch_phase<0>(grid, stream, p); launch_phase<1>(grid, stream, p); launch_phase<2>(grid, stream, p); launch_phase<3>(grid, stream, p);
    launch_phase<4>(grid, stream, p); launch_phase<5>(grid, stream, p); launch_phase<6>(grid, stream, p); launch_phase<7>(grid, stream, p);
    launch_phase<8>(grid, stream, p); launch_phase<9>(grid, stream, p); launch_phase<10>(grid, stream, p);
#endif
}
```
